# Optimizing an MI355X kernel written in HIP

```python
import math
import jax, jax.numpy as jnp
from jax import lax
import numpy as np

D_MODEL = 1024
BATCH = 16
SEQ = 4096
DEPTH = 1

RWKV_HEADS = 8
RWKV_HEAD_DIM = 64
RWKV_DIM = RWKV_HEADS * RWKV_HEAD_DIM
DECAY_LORA = 64
AAA_LORA = 64
GATE_LORA = 128
GN_EPS = 64e-5
MLA_HEADS = 8
QK_NOPE_DIM = 64
QK_ROPE_DIM = 32
QK_HEAD_DIM = QK_NOPE_DIM + QK_ROPE_DIM
V_HEAD_DIM = 64
MLA_DIM = MLA_HEADS * V_HEAD_DIM
Q_LORA = 512
KV_LORA = 256
ROPE_THETA = 10000.0
Q_BLOCK = 128
D_FF = int(math.ceil(8 * D_MODEL / 3 / 256)) * 256
LN_EPS = 1e-5
RMS_EPS = 1e-6
ALPHA = (2.0 * DEPTH) ** 0.25
BETA = (8.0 * DEPTH) ** -0.25
RWKV_SPLITS = (RWKV_DIM, RWKV_DIM, RWKV_DIM, DECAY_LORA, AAA_LORA, GATE_LORA)
SHIFT_COLS = 3 * RWKV_DIM + DECAY_LORA + AAA_LORA + GATE_LORA
REST_SPLITS = (Q_LORA, KV_LORA, QK_ROPE_DIM, D_MODEL, D_MODEL)
D_IN = SHIFT_COLS + Q_LORA + KV_LORA + QK_ROPE_DIM + 2 * D_MODEL

kernel_name = "hybrid_rwkv7_mla_gated_deepnorm"


def _split(z, sizes):
    outs, start = [], 0
    for s in sizes:
        outs.append(z[..., start:start + s])
        start += s
    return outs


def layer_norm(x, g, b, eps=LN_EPS):
    xf = x.astype(jnp.float32)
    mu = jnp.mean(xf, axis=-1, keepdims=True)
    var = jnp.mean(jnp.square(xf - mu), axis=-1, keepdims=True)
    return ((xf - mu) * lax.rsqrt(var + eps) * g.astype(jnp.float32) + b.astype(jnp.float32)).astype(x.dtype)


def rms_norm(x, g, eps=RMS_EPS):
    xf = x.astype(jnp.float32)
    ms = jnp.mean(jnp.square(xf), axis=-1, keepdims=True)
    return (xf * lax.rsqrt(ms + eps) * g.astype(jnp.float32)).astype(x.dtype)


def rope_cos_sin(positions):
    inv_freq = ROPE_THETA ** (-jnp.arange(0, QK_ROPE_DIM, 2, dtype=jnp.float32) / QK_ROPE_DIM)
    ang = positions.astype(jnp.float32)[..., None] * inv_freq
    return jnp.cos(ang), jnp.sin(ang)


def apply_rope(x, cos, sin):
    half = x.shape[-1] // 2
    x1, x2 = x[..., :half], x[..., half:]
    cos = cos.astype(x.dtype)
    sin = sin.astype(x.dtype)
    return jnp.concatenate([x1 * cos - x2 * sin, x2 * cos + x1 * sin], axis=-1)


def rwkv7_scan(r, w, k, v, a, b):
    B, S, H, N = r.shape
    to_time = lambda t: jnp.moveaxis(t.astype(jnp.float32), 1, 0)
    xs = tuple(to_time(t) for t in (r, w, k, v, a, b))

    def step(state, inp):
        r_t, w_t, k_t, v_t, a_t, b_t = inp
        sa = jnp.einsum('bhvk,bhk->bhv', state, a_t)
        state = state * w_t[:, :, None, :] + sa[..., None] * b_t[:, :, None, :] + v_t[..., None] * k_t[:, :, None, :]
        y = jnp.einsum('bhvk,bhk->bhv', state, r_t)
        return state, y

    state0 = jnp.zeros((B, H, N, N), jnp.float32)
    _, ys = lax.scan(step, state0, xs)
    return jnp.moveaxis(ys, 0, 1).astype(r.dtype)


def rwkv7_branch(z_r, z_k, z_v, z_wd, z_ad, z_gd, w_decay_up, w_decay_base, w_aaa_up, w_aaa_base,
                 w_gate_up, k_k, k_a, r_k, lnx_g, lnx_b):
    B, S, _ = z_r.shape
    H, N = RWKV_HEADS, RWKV_HEAD_DIM
    w_log = -jax.nn.softplus(-(w_decay_base + jnp.tanh(z_wd) @ w_decay_up)) - 0.5
    decay = jnp.exp(-jnp.exp(w_log.astype(jnp.float32)))
    a = jax.nn.sigmoid(w_aaa_base + z_ad @ w_aaa_up)
    g = jax.nn.sigmoid(z_gd) @ w_gate_up
    kk = (z_k * k_k).reshape(B, S, H, N)
    kk_f = kk.astype(jnp.float32)
    kk = (kk_f / jnp.maximum(jnp.sqrt(jnp.sum(kk_f * kk_f, axis=-1, keepdims=True)), 1e-12)).astype(z_k.dtype)
    k = z_k * (1.0 + (a - 1.0) * k_a)
    heads = lambda t: t.reshape(B, S, H, N)
    r, k, v, a_h, decay = heads(z_r), heads(k), heads(z_v), heads(a), heads(decay)
    y = rwkv7_scan(r, decay, k, v, -kk, kk * a_h)
    y = layer_norm(y, lnx_g.reshape(H, N), lnx_b.reshape(H, N), eps=GN_EPS)
    bonus = jnp.sum(r * k * r_k, axis=-1, keepdims=True) * v
    return (y + bonus).reshape(B, S, RWKV_DIM) * g


def mla_branch(c_q, c_kv, k_pe_raw, positions, q_norm_g, w_uq, kv_norm_g, w_ukv):
    B, S, _ = c_q.shape
    H = MLA_HEADS
    cos, sin = rope_cos_sin(positions)
    q = (rms_norm(c_q, q_norm_g) @ w_uq).reshape(B, S, H, QK_HEAD_DIM)
    q_nope, q_pe = q[..., :QK_NOPE_DIM], q[..., QK_NOPE_DIM:]
    q_pe = apply_rope(q_pe, cos[:, :, None, :], sin[:, :, None, :])
    kv = (rms_norm(c_kv, kv_norm_g) @ w_ukv).reshape(B, S, H, QK_NOPE_DIM + V_HEAD_DIM)
    k_nope, v = kv[..., :QK_NOPE_DIM], kv[..., QK_NOPE_DIM:]
    k_pe = apply_rope(k_pe_raw, cos, sin)
    scale = QK_HEAD_DIM ** -0.5
    nb = S // Q_BLOCK
    to_blocks = lambda t: jnp.moveaxis(t.reshape(B, nb, Q_BLOCK, H, t.shape[-1]), 1, 0)
    key_idx = jnp.arange(S)

    def attend(args):
        qn, qp, blk = args
        s = jnp.einsum('bqhd,bkhd->bhqk', qn, k_nope) + jnp.einsum('bqhr,bkr->bhqk', qp, k_pe)
        s = s.astype(jnp.float32) * scale
        q_idx = blk * Q_BLOCK + jnp.arange(Q_BLOCK)
        mask = key_idx[None, :] <= q_idx[:, None]
        p = jax.nn.softmax(jnp.where(mask, s, -jnp.inf), axis=-1).astype(v.dtype)
        return jnp.einsum('bhqk,bkhd->bqhd', p, v)

    o = lax.map(attend, (to_blocks(q_nope), to_blocks(q_pe), jnp.arange(nb)))
    return jnp.moveaxis(o, 0, 1).reshape(B, S, MLA_DIM)


def hybrid_layer(x, positions, w_in, mu_shift, w_decay_up, w_decay_base, w_aaa_up, w_aaa_base, w_gate_up,
                 k_k, k_a, r_k, lnx_g, lnx_b, q_norm_g, w_uq, kv_norm_g, w_ukv, w_proj_rwkv, w_proj_mla,
                 w_out, ln1_g, ln1_b, w_ffn_gate, w_ffn_up, w_ffn_down, ln2_g, ln2_b):
    z = x @ w_in
    zs, zm = z[..., :SHIFT_COLS], z[..., SHIFT_COLS:]
    zs_prev = jnp.pad(zs, ((0, 0), (1, 0), (0, 0)))[:, :-1]
    zs = zs + mu_shift * (zs_prev - zs)
    z_r, z_k, z_v, z_wd, z_ad, z_gd = _split(zs, RWKV_SPLITS)
    c_q, c_kv, k_pe_raw, gate_r, gate_m = _split(zm, REST_SPLITS)
    y_r = rwkv7_branch(z_r, z_k, z_v, z_wd, z_ad, z_gd, w_decay_up, w_decay_base, w_aaa_up, w_aaa_base,
                       w_gate_up, k_k, k_a, r_k, lnx_g, lnx_b)
    y_m = mla_branch(c_q, c_kv, k_pe_raw, positions, q_norm_g, w_uq, kv_norm_g, w_ukv)
    merged = jax.nn.sigmoid(gate_r) * (y_r @ w_proj_rwkv) + jax.nn.sigmoid(gate_m) * (y_m @ w_proj_mla)
    h = layer_norm(ALPHA * x + merged @ w_out, ln1_g, ln1_b)
    ffn = (jax.nn.silu(h @ w_ffn_gate) * (h @ w_ffn_up)) @ w_ffn_down
    return layer_norm(ALPHA * h + ffn, ln2_g, ln2_b)


def setup_inputs(seed: int = 0) -> dict:
    key = jax.random.key(seed)
    ks = jax.random.split(key, 32)
    L = DEPTH
    f32 = jnp.float32

    def nrm(k, shape, scale):
        return jax.random.normal(k, shape, f32) * scale

    x = jax.random.normal(ks[0], (BATCH, SEQ, D_MODEL), f32)
    offset = jax.random.randint(ks[1], (BATCH, 1), 0, 1024, dtype=jnp.int32)
    positions = offset + jnp.arange(SEQ, dtype=jnp.int32)[None, :]
    col_scale = jnp.ones((D_IN,), f32).at[2 * RWKV_DIM:3 * RWKV_DIM].set(BETA)
    w_in = nrm(ks[2], (L, D_MODEL, D_IN), D_MODEL ** -0.5) * col_scale
    mu_shift = jax.random.uniform(ks[3], (L, SHIFT_COLS), f32)
    w_decay_up = nrm(ks[4], (L, DECAY_LORA, RWKV_DIM), 0.1 * DECAY_LORA ** -0.5)
    w_decay_base = jax.random.uniform(ks[5], (L, RWKV_DIM), f32, minval=-6.0, maxval=-1.0)
    w_aaa_up = nrm(ks[6], (L, AAA_LORA, RWKV_DIM), AAA_LORA ** -0.5)
    w_aaa_base = nrm(ks[7], (L, RWKV_DIM), 0.1)
    w_gate_up = nrm(ks[8], (L, GATE_LORA, RWKV_DIM), GATE_LORA ** -0.5)
    k_k = 0.85 + nrm(ks[9], (L, RWKV_DIM), 0.02)
    k_a = 1.0 + nrm(ks[10], (L, RWKV_DIM), 0.02)
    r_k = nrm(ks[11], (L, RWKV_HEADS, RWKV_HEAD_DIM), 0.1)
    lnx_g = 1.0 + nrm(ks[12], (L, RWKV_DIM), 0.02)
    lnx_b = nrm(ks[13], (L, RWKV_DIM), 0.02)
    q_norm_g = 1.0 + nrm(ks[14], (L, Q_LORA), 0.02)
    w_uq = nrm(ks[15], (L, Q_LORA, MLA_HEADS * QK_HEAD_DIM), Q_LORA ** -0.5)
    kv_norm_g = 1.0 + nrm(ks[16], (L, KV_LORA), 0.02)
    kv_col_scale = jnp.tile(jnp.concatenate([jnp.ones((QK_NOPE_DIM,), f32), jnp.full((V_HEAD_DIM,), BETA, f32)]), MLA_HEADS)
    w_ukv = nrm(ks[17], (L, KV_LORA, MLA_HEADS * (QK_NOPE_DIM + V_HEAD_DIM)), KV_LORA ** -0.5) * kv_col_scale
    w_proj_rwkv = nrm(ks[18], (L, RWKV_DIM, D_MODEL), BETA * RWKV_DIM ** -0.5)
    w_proj_mla = nrm(ks[19], (L, MLA_DIM, D_MODEL), BETA * MLA_DIM ** -0.5)
    w_out = nrm(ks[20], (L, D_MODEL, D_MODEL), BETA * D_MODEL ** -0.5)
    ln1_g = 1.0 + nrm(ks[21], (L, D_MODEL), 0.02)
    ln1_b = nrm(ks[22], (L, D_MODEL), 0.02)
    w_ffn_gate = nrm(ks[23], (L, D_MODEL, D_FF), BETA * D_MODEL ** -0.5)
    w_ffn_up = nrm(ks[24], (L, D_MODEL, D_FF), BETA * D_MODEL ** -0.5)
    w_ffn_down = nrm(ks[25], (L, D_FF, D_MODEL), BETA * D_FF ** -0.5)
    ln2_g = 1.0 + nrm(ks[26], (L, D_MODEL), 0.02)
    ln2_b = nrm(ks[27], (L, D_MODEL), 0.02)
    return {"x": x, "positions": positions, "w_in": w_in, "mu_shift": mu_shift,
            "w_decay_up": w_decay_up, "w_decay_base": w_decay_base, "w_aaa_up": w_aaa_up,
            "w_aaa_base": w_aaa_base, "w_gate_up": w_gate_up, "k_k": k_k, "k_a": k_a, "r_k": r_k,
            "lnx_g": lnx_g, "lnx_b": lnx_b, "q_norm_g": q_norm_g, "w_uq": w_uq,
            "kv_norm_g": kv_norm_g, "w_ukv": w_ukv, "w_proj_rwkv": w_proj_rwkv,
            "w_proj_mla": w_proj_mla, "w_out": w_out, "ln1_g": ln1_g, "ln1_b": ln1_b,
            "w_ffn_gate": w_ffn_gate, "w_ffn_up": w_ffn_up, "w_ffn_down": w_ffn_down,
            "ln2_g": ln2_g, "ln2_b": ln2_b}


def reference(x, positions, w_in, mu_shift, w_decay_up, w_decay_base, w_aaa_up, w_aaa_base, w_gate_up,
              k_k, k_a, r_k, lnx_g, lnx_b, q_norm_g, w_uq, kv_norm_g, w_ukv, w_proj_rwkv, w_proj_mla,
              w_out, ln1_g, ln1_b, w_ffn_gate, w_ffn_up, w_ffn_down, ln2_g, ln2_b):
    h = x
    for l in range(DEPTH):
        h = hybrid_layer(h, positions, w_in[l], mu_shift[l], w_decay_up[l], w_decay_base[l], w_aaa_up[l],
                         w_aaa_base[l], w_gate_up[l], k_k[l], k_a[l], r_k[l], lnx_g[l], lnx_b[l],
                         q_norm_g[l], w_uq[l], kv_norm_g[l], w_ukv[l], w_proj_rwkv[l], w_proj_mla[l],
                         w_out[l], ln1_g[l], ln1_b[l], w_ffn_gate[l], w_ffn_up[l], w_ffn_down[l],
                         ln2_g[l], ln2_b[l])
    return h
```

```cpp
#include <hip/hip_runtime.h>
#include <hip/hip_cooperative_groups.h>
#include <cstdio>
#include <cstdint>
namespace cg = cooperative_groups;

#ifndef PGRP
#define PGRP 4
#endif
#ifndef P3_OVERLAP
#define P3_OVERLAP 1
#endif
#ifndef GEMM_8PHASE
#define GEMM_8PHASE 1
#endif
#define LAS __attribute__((address_space(3)))
typedef unsigned short bf16_t;
typedef short bf16x8 __attribute__((ext_vector_type(8)));
typedef float f32x4 __attribute__((ext_vector_type(4)));
typedef float f32x16 __attribute__((ext_vector_type(16)));
typedef unsigned u32x4 __attribute__((ext_vector_type(4)));
typedef unsigned u32x2 __attribute__((ext_vector_type(2)));

constexpr int T_TOK = 65536, SEQ = 4096, NPAN = 256;
constexpr size_t MiB = 1ull << 20;
constexpr size_t OFF_WIN = 0;
constexpr size_t OFF_WLORA = OFF_WIN + 4864ull * 1024 * 2;
constexpr size_t OFF_WUQ = OFF_WLORA + 1536ull * 256 * 2;
constexpr size_t OFF_WUKV = OFF_WUQ + 768ull * 512 * 2;
constexpr size_t OFF_WPR = OFF_WUKV + 1024ull * 256 * 2;
constexpr size_t OFF_WPM = OFF_WPR + 1024ull * 512 * 2;
constexpr size_t OFF_WOUT = OFF_WPM + 1024ull * 512 * 2;
constexpr size_t OFF_WGU = OFF_WOUT + 1024ull * 1024 * 2;
constexpr size_t OFF_WD = OFF_WGU + 5632ull * 1024 * 2;
constexpr size_t OFF_WEND = OFF_WD + 1024ull * 2816 * 2;
static_assert(OFF_WEND <= 34 * MiB, "weights region");
constexpr size_t OFF_ROPE = 34 * MiB;
constexpr size_t OFF_RSTDQ = 42 * MiB;
constexpr size_t OFF_RSTDKV = OFF_RSTDQ + 256 * 1024;
constexpr size_t OFF_BONUS = 43 * MiB;
constexpr size_t OFF_ZB = 45 * MiB;
constexpr size_t OFF_ZS = 48 * MiB;
constexpr size_t OFF_ZC = 272 * MiB;
constexpr size_t OFF_KPR = 368 * MiB;
constexpr size_t OFF_GATES = 372 * MiB;
constexpr size_t OFF_KK = 628 * MiB;
constexpr size_t OFF_BB = 692 * MiB;
constexpr size_t OFF_DEC = 756 * MiB;
constexpr size_t OFF_G = 884 * MiB;
constexpr size_t OFF_Y = 948 * MiB;
constexpr size_t OFF_ACT = 48 * MiB;
constexpr size_t DO_Q = 0, DO_KN = 96 * MiB, DO_VT = 160 * MiB, DO_KPE = 224 * MiB;

constexpr int LDS_BYTES = 147520;
constexpr float ALPHA_F = 1.189207115002721f;
constexpr float QSCALE = 0.10206207261596575f * 1.4426950408889634f;

struct Params { const float* in[28]; float* out; unsigned char* ws; int ph_lo, ph_hi; };

__device__ __constant__ float INVF[16] = {1.0f, 0.5623413251903491f, 0.31622776601683794f, 0.1778279410038923f,
                                          0.1f, 0.05623413251903491f, 0.031622776601683794f, 0.01778279410038923f,
                                          0.01f, 0.005623413251903491f, 0.0031622776601683794f, 0.001778279410038923f,
                                          0.001f, 0.0005623413251903491f, 0.00031622776601683794f, 0.0001778279410038923f};

typedef __bf16 bf16x2_t __attribute__((ext_vector_type(2)));
typedef float f32x2_t __attribute__((ext_vector_type(2)));
__device__ __forceinline__ unsigned pk2(float lo, float hi) { return __builtin_bit_cast(unsigned, __builtin_convertvector((f32x2_t){lo, hi}, bf16x2_t)); }
__device__ __forceinline__ float bflo(unsigned u) { return __uint_as_float(u << 16); }
__device__ __forceinline__ float bfhi(unsigned u) { return __uint_as_float(u & 0xffff0000u); }
__device__ __forceinline__ float bf1(bf16_t u) { return __uint_as_float(((unsigned)u) << 16); }
__device__ __forceinline__ float sigmoidf_(float x) { return __builtin_amdgcn_rcpf(1.0f + __expf(-x)); }
__device__ __forceinline__ float tanhf_(float x) { return 1.0f - 2.0f * __builtin_amdgcn_rcpf(1.0f + __expf(2.0f * x)); }
#define LDS_WAIT() asm volatile("s_waitcnt lgkmcnt(0)" ::: "memory")
__device__ __forceinline__ int fresh_tid() { int t = threadIdx.x; asm volatile("" : "+v"(t)); return t; }

constexpr int BM = 256, BK = 64, HALF = 128, HTB = HALF * BK * 2;
__device__ __forceinline__ int lds_byte(int r, int c) { const int st = (r >> 4) * 2 + (c >> 5), rr = r & 15, cc = c & 31, ob = rr * 64 + cc * 2; return st * 1024 + (ob ^ (((ob >> 9) & 1) << 5)); }
__device__ __forceinline__ void stage_rc(int b, int& R, int& C) { const int st = b / 1024, sb = b % 1024, swz = sb ^ (((sb >> 9) & 1) << 5); R = (st >> 1) * 16 + swz / 64; C = (st & 1) * 32 + (swz % 64) / 2; }

template <bool TR, typename Epi>
__device__ __forceinline__ void gemm_unit(const bf16_t* __restrict__ A, int lda, const bf16_t* __restrict__ Bt, int ldb, int K, int brow, int bcol, LAS unsigned char* lds, Epi epi,
                                          bool pre = false, bool nxt = false, int nbrow = 0, int nbcol = 0) {
    const int tid = fresh_tid(), wid = __builtin_amdgcn_readfirstlane(tid >> 6), lane = tid & 63, wr = wid >> 2, wc = wid & 3, fr = lane & 15, fq = lane >> 4;
    unsigned voffA[2], voffB[2];
#pragma unroll
    for (int i = 0; i < 2; ++i) { int r, c; stage_rc(tid * 16 + i * 8192, r, c); voffA[i] = (unsigned)(r * lda + c) * 2u; voffB[i] = (unsigned)(r * ldb + c) * 2u; }
    const bf16_t* Ab0 = A + (size_t)brow * lda; const bf16_t* Ab1 = Ab0 + (size_t)HALF * lda;
    const bf16_t* Bb0 = Bt + (size_t)bcol * ldb; const bf16_t* Bb1 = Bb0 + (size_t)HALF * ldb;
    const unsigned ldsw = (unsigned)wid * 1024u;
    const int aoff = lds_byte(wr * 64 + fr, fq * 8), boff = lds_byte(wc * 32 + fr, fq * 8);
#define G_SA(b, h) (((b) * 2 + (h)) * HTB)
#define G_SB(b, h) ((4 + (b) * 2 + (h)) * HTB)
#define G_STAGE(bufoff, gbase, voff, kt) do { const char* _gb = (const char*)((gbase) + (kt) * BK); _Pragma("unroll") for (int _i = 0; _i < 2; ++_i) \
        __builtin_amdgcn_global_load_lds((const unsigned*)(_gb + (voff)[_i]), (LAS unsigned*)(lds + (bufoff) + ldsw + _i * 8192), 16, 0, 0); } while (0)
#define G_LDA(dst, b, h) do { _Pragma("unroll") for (int m = 0; m < 4; ++m) _Pragma("unroll") for (int k = 0; k < 2; ++k) dst[m][k] = *(const LAS bf16x8*)(lds + G_SA(b, h) + aoff + m * 2048 + k * 1024); } while (0)
#define G_LDB(dst, b, h) do { _Pragma("unroll") for (int n = 0; n < 2; ++n) _Pragma("unroll") for (int k = 0; k < 2; ++k) dst[n][k] = *(const LAS bf16x8*)(lds + G_SB(b, h) + boff + n * 2048 + k * 1024); } while (0)
#define G_MMA(ai, bj, At_, Bt_) do { __builtin_amdgcn_s_setprio(1); _Pragma("unroll") for (int m = 0; m < 4; ++m) _Pragma("unroll") for (int n = 0; n < 2; ++n) _Pragma("unroll") for (int k = 0; k < 2; ++k) \
        acc[ai][bj][m][n] = TR ? __builtin_amdgcn_mfma_f32_16x16x32_bf16(Bt_[n][k], At_[m][k], acc[ai][bj][m][n], 0, 0, 0) \
                               : __builtin_amdgcn_mfma_f32_16x16x32_bf16(At_[m][k], Bt_[n][k], acc[ai][bj][m][n], 0, 0, 0); __builtin_amdgcn_s_setprio(0); } while (0)
#define G_WAIT_V(n) asm volatile("s_waitcnt vmcnt(" #n ")" ::: "memory")
#define G_WAIT_L(n) asm volatile("s_waitcnt lgkmcnt(" #n ")" ::: "memory")
#define G_BAR __builtin_amdgcn_s_barrier()
#define G_SCHED do { asm volatile("" ::: "memory"); __builtin_amdgcn_sched_barrier(0); } while (0)
    f32x4 acc[2][2][4][2];
#pragma unroll
    for (int a = 0; a < 2; ++a)
#pragma unroll
        for (int b = 0; b < 2; ++b)
#pragma unroll
            for (int m = 0; m < 4; ++m)
#pragma unroll
                for (int n = 0; n < 2; ++n) acc[a][b][m][n] = (f32x4){0.f, 0.f, 0.f, 0.f};
    bf16x8 At[4][2], B0[2][2], B1[2][2];
    const int nt = K / BK;
#if GEMM_8PHASE
    if (!pre) {
        asm volatile("s_waitcnt vmcnt(0) lgkmcnt(0)" ::: "memory");
        G_BAR;
        asm volatile("" ::: "memory");
        G_STAGE(G_SB(0, 0), Bb0, voffB, 0); G_STAGE(G_SA(0, 0), Ab0, voffA, 0);
        G_STAGE(G_SB(0, 1), Bb1, voffB, 0); G_STAGE(G_SA(0, 1), Ab1, voffA, 0);
        if (wr == 1) G_BAR;
        G_WAIT_V(4); G_BAR;
        G_STAGE(G_SB(1, 0), Bb0, voffB, 1); G_STAGE(G_SA(1, 0), Ab0, voffA, 1); G_STAGE(G_SB(1, 1), Bb1, voffB, 1);
        G_WAIT_V(6); G_BAR;
    }
    if (pre) { if (wr == 1) G_BAR; }
    const bf16_t* nA0 = nxt ? A + (size_t)nbrow * lda : Ab0; const bf16_t* nA1 = nA0 + (size_t)HALF * lda;
    const bf16_t* nB0 = nxt ? Bt + (size_t)nbcol * ldb : Bb0; const bf16_t* nB1 = nB0 + (size_t)HALF * ldb;
    for (int t = 0; t < nt; t += 2) {
        const bool last = (t == nt - 2);
        const bf16_t* pa0 = last ? nA0 : Ab0; const bf16_t* pa1 = last ? nA1 : Ab1; const bf16_t* pb0 = last ? nB0 : Bb0; const bf16_t* pb1 = last ? nB1 : Bb1;
        const int k2 = last ? 0 : t + 2, k3 = k2 + 1;
        G_LDB(B0, 0, 0); G_SCHED; G_LDA(At, 0, 0); G_STAGE(G_SA(1, 1), Ab1, voffA, t + 1);
        G_WAIT_L(8); G_BAR; G_WAIT_L(0); G_MMA(0, 0, At, B0); G_BAR; G_SCHED;
        G_LDB(B1, 0, 1); G_STAGE(G_SB(0, 0), pb0, voffB, k2);
        G_BAR; G_WAIT_L(0); G_MMA(0, 1, At, B1); G_BAR;
        G_LDA(At, 0, 1); G_STAGE(G_SA(0, 0), pa0, voffA, k2);
        G_BAR; G_WAIT_L(0); G_MMA(1, 0, At, B0); G_BAR; G_SCHED;
        G_STAGE(G_SB(0, 1), pb1, voffB, k2);
        G_WAIT_V(6); G_BAR; G_MMA(1, 1, At, B1); G_BAR;
        G_LDB(B0, 1, 0); G_SCHED; G_LDA(At, 1, 0); G_STAGE(G_SA(0, 1), pa1, voffA, k2);
        G_WAIT_L(8); G_BAR; G_WAIT_L(0); G_MMA(0, 0, At, B0); G_BAR; G_SCHED;
        G_LDB(B1, 1, 1); G_STAGE(G_SB(1, 0), pb0, voffB, k3);
        G_BAR; G_WAIT_L(0); G_MMA(0, 1, At, B1); G_BAR;
        G_LDA(At, 1, 1); G_STAGE(G_SA(1, 0), pa0, voffA, k3);
        G_BAR; G_WAIT_L(0); G_MMA(1, 0, At, B0); G_BAR; G_SCHED;
        G_STAGE(G_SB(1, 1), pb1, voffB, k3);
        G_WAIT_V(6); G_BAR; G_MMA(1, 1, At, B1); G_BAR;
    }
    if (!nxt) asm volatile("s_waitcnt vmcnt(0)" ::: "memory");
    if (wr == 0) G_BAR;
#else
    asm volatile("s_waitcnt vmcnt(0) lgkmcnt(0)" ::: "memory");
    G_BAR;
    asm volatile("" ::: "memory");
    G_STAGE(G_SB(0, 0), Bb0, voffB, 0); G_STAGE(G_SA(0, 0), Ab0, voffA, 0);
    G_STAGE(G_SB(0, 1), Bb1, voffB, 0); G_STAGE(G_SA(0, 1), Ab1, voffA, 0);
    for (int t = 0; t < nt; ++t) {
        G_WAIT_V(0); G_BAR;
        asm volatile("" ::: "memory");
        const int cb = (t & 1) * 2 * HTB, nb = cb ^ (2 * HTB);
        if (t + 1 < nt) { G_STAGE(4 * HTB + nb, Bb0, voffB, t + 1); G_STAGE(nb, Ab0, voffA, t + 1); G_STAGE(5 * HTB + nb, Bb1, voffB, t + 1); G_STAGE(HTB + nb, Ab1, voffA, t + 1); }
        LAS unsigned char* la = lds + cb + aoff; LAS unsigned char* lb = lds + 4 * HTB + cb + boff;
#define X_LDA(dst, h) do { _Pragma("unroll") for (int m = 0; m < 4; ++m) _Pragma("unroll") for (int k = 0; k < 2; ++k) dst[m][k] = *(const LAS bf16x8*)(la + (h) * HTB + m * 2048 + k * 1024); } while (0)
#define X_LDB(dst, h) do { _Pragma("unroll") for (int n = 0; n < 2; ++n) _Pragma("unroll") for (int k = 0; k < 2; ++k) dst[n][k] = *(const LAS bf16x8*)(lb + (h) * HTB + n * 2048 + k * 1024); } while (0)
        X_LDB(B0, 0); X_LDA(At, 0); X_LDB(B1, 1); G_SCHED; G_MMA(0, 0, At, B0); G_SCHED;
        G_MMA(0, 1, At, B1); G_SCHED;
        X_LDA(At, 1); G_SCHED; G_MMA(1, 0, At, B0); G_MMA(1, 1, At, B1); G_SCHED;
    }
#endif
    G_WAIT_L(0);
    asm volatile("" ::: "memory");
    { int fr_ = fr, fq_ = fq, wr_ = wr, wc_ = wc;
      asm volatile("" : "+v"(fr_), "+v"(fq_), "+v"(wr_), "+v"(wc_));
      epi(acc, wr_, wc_, fr_, fq_); }
}

__device__ __forceinline__ int perm32(int d) { return 8 * ((d >> 2) & 3) + 4 * (d >> 4) + (d & 3); }
__device__ __forceinline__ void wt_block(const float* src, int ldsrc, int col0, int ksrc0, const float* rowscale, bf16_t* dst, int Kdst, int n0, int k0, LAS float* scr, int lane, bool perm) {
#pragma unroll 8
    for (int i = 0; i < 32; ++i) {
        const int kk = 2 * i + (lane >> 5);
        float v = 0.f;
        if (src) { v = src[(size_t)(ksrc0 + kk) * ldsrc + col0 + (lane & 31)]; if (rowscale) v *= rowscale[ksrc0 + kk]; }
        scr[kk * 33 + (lane & 31)] = v;
    }
    LDS_WAIT();
    const int c = lane & 7;
#pragma unroll
    for (int j = 0; j < 4; ++j) {
        const int n = (lane >> 3) + 8 * j; const LAS float* s = scr + (8 * c) * 33 + (perm ? perm32(n) : n);
        u32x4 o; o.x = pk2(s[0 * 33], s[1 * 33]); o.y = pk2(s[2 * 33], s[3 * 33]); o.z = pk2(s[4 * 33], s[5 * 33]); o.w = pk2(s[6 * 33], s[7 * 33]);
        *(u32x4*)(dst + (size_t)(n0 + n) * Kdst + k0 + 8 * c) = o;
    }
    LDS_WAIT();
}

__device__ __forceinline__ void phase0(const Params& p, LAS unsigned char* lds) {
    const int tid = threadIdx.x, lane = tid & 63, wid = tid >> 6;
    const int gw = blockIdx.x * 8 + wid, NGW = gridDim.x * 8;
    LAS float* scr = (LAS float*)(lds + wid * 16384);
    unsigned char* ws = p.ws;
    for (int it = gw; it < 8192; it += NGW) {
        bool permw = false;
        int r = it; const float* src = nullptr; int ldsrc = 0, col0 = 0, ksrc0 = 0, Kd = 0, n0 = 0, k0 = 0; const float* rs = nullptr; bf16_t* dst = nullptr;
        if (r < 2432) { permw = true; const int nb = r % 152, kb = r / 152; n0 = nb * 32; k0 = kb * 64; Kd = 1024; dst = (bf16_t*)(ws + OFF_WIN); ldsrc = 4640; ksrc0 = k0;
            if (n0 < 2560) { src = p.in[2]; col0 = n0; } else if (n0 < 4608) { src = p.in[2]; col0 = n0 + 32; } else if (n0 < 4640) { src = p.in[2]; col0 = n0 - 4608 + 2560; } }
        else if ((r -= 2432) < 192) { permw = true; const int nb = r % 48, kb = r / 48; n0 = nb * 32; k0 = kb * 64; Kd = 256; dst = (bf16_t*)(ws + OFF_WLORA); ldsrc = 512;
            if (n0 < 512) { if (k0 == 0) { src = p.in[4]; col0 = n0; ksrc0 = 0; } }
            else if (n0 < 1024) { if (k0 == 64) { src = p.in[6]; col0 = n0 - 512; ksrc0 = 0; } }
            else { if (k0 >= 128) { src = p.in[8]; col0 = n0 - 1024; ksrc0 = k0 - 128; } } }
        else if ((r -= 192) < 192) { const int nb = r % 24, kb = r / 24; n0 = nb * 32; k0 = kb * 64; Kd = 512; dst = (bf16_t*)(ws + OFF_WUQ); ldsrc = 768; ksrc0 = k0; src = p.in[15]; rs = p.in[14];
            permw = n0 < 512;
            if (n0 < 512) col0 = (n0 >> 6) * 96 + (n0 & 63); else col0 = ((n0 - 512) >> 5) * 96 + 64; }
        else if ((r -= 192) < 128) { const int nb = r % 32, kb = r / 32; n0 = nb * 32; k0 = kb * 64; Kd = 256; dst = (bf16_t*)(ws + OFF_WUKV); ldsrc = 1024; ksrc0 = k0; src = p.in[17]; rs = p.in[16];
            permw = n0 < 512;
            if (n0 < 512) col0 = (n0 >> 6) * 128 + (n0 & 63); else col0 = ((n0 - 512) >> 6) * 128 + 64 + ((n0 - 512) & 63); }
        else if ((r -= 128) < 256) { permw = true; const int nb = r % 32, kb = r / 32; n0 = nb * 32; k0 = kb * 64; Kd = 512; dst = (bf16_t*)(ws + OFF_WPR); ldsrc = 1024; ksrc0 = k0; src = p.in[18]; col0 = n0; }
        else if ((r -= 256) < 256) { permw = true; const int nb = r % 32, kb = r / 32; n0 = nb * 32; k0 = kb * 64; Kd = 512; dst = (bf16_t*)(ws + OFF_WPM); ldsrc = 1024; ksrc0 = k0; src = p.in[19]; col0 = n0; }
        else if ((r -= 256) < 512) { const int nb = r % 32, kb = r / 32; n0 = nb * 32; k0 = kb * 64; Kd = 1024; dst = (bf16_t*)(ws + OFF_WOUT); ldsrc = 1024; ksrc0 = k0; src = p.in[20]; col0 = n0; }
        else if ((r -= 512) < 2816) { permw = true; const int nb = r % 176, kb = r / 176; n0 = nb * 32; k0 = kb * 64; Kd = 1024; dst = (bf16_t*)(ws + OFF_WGU); ldsrc = 2816; ksrc0 = k0;
            const int j = n0 >> 8, w = n0 & 255; if (w < 128) { src = p.in[23]; col0 = j * 128 + w; } else { src = p.in[24]; col0 = j * 128 + w - 128; } }
        else { r -= 2816; const int nb = r % 32, kb = r / 32; n0 = nb * 32; k0 = kb * 64; Kd = 2816; dst = (bf16_t*)(ws + OFF_WD); ldsrc = 1024; ksrc0 = k0; src = p.in[25]; col0 = n0; }
        wt_block(src, ldsrc, col0, ksrc0, rs, dst, Kd, n0, k0, scr, lane, permw);
    }
    {
        const size_t gt = (size_t)blockIdx.x * 512 + tid, NT = (size_t)gridDim.x * 512;
        const f32x4* x4 = (const f32x4*)p.in[0]; u32x4* o = (u32x4*)p.out;
        for (size_t i = gt; i < (size_t)T_TOK * 1024 / 8; i += 8 * NT) {
            f32x4 a[8], b[8];
#pragma unroll
            for (int j = 0; j < 8; ++j) { const size_t ii = i + j * NT; if (ii < (size_t)T_TOK * 1024 / 8) { a[j] = x4[2 * ii]; b[j] = x4[2 * ii + 1]; } }
#pragma unroll
            for (int j = 0; j < 8; ++j) { const size_t ii = i + j * NT; if (ii < (size_t)T_TOK * 1024 / 8) {
                u32x4 w; w.x = pk2(a[j].x, a[j].y); w.y = pk2(a[j].z, a[j].w); w.z = pk2(b[j].x, b[j].y); w.w = pk2(b[j].z, b[j].w);
                o[ii] = w; } }
        }
        const int* pos = (const int*)p.in[1];
        float* ct = (float*)(ws + OFF_ROPE); float* st = ct + (size_t)T_TOK * 16;
        for (size_t i = gt; i < (size_t)T_TOK * 16; i += NT) {
            const int t = (int)(i >> 4), f = (int)(i & 15);
            const float ang = (float)pos[t] * INVF[f];
            double rv = (double)ang * 0.15915494309189535; rv -= floor(rv);
            const float rf = (float)rv;
            ct[i] = __builtin_amdgcn_cosf(rf); st[i] = __builtin_amdgcn_sinf(rf);
        }
    }
}

__device__ __forceinline__ void store8bf(bf16_t* p, f32x4 a, f32x4 b) { u32x4 w; w.x = pk2(a[0], a[1]); w.y = pk2(a[2], a[3]); w.z = pk2(b[0], b[1]); w.w = pk2(b[2], b[3]); *(u32x4*)p = w; }
__device__ __forceinline__ void store4bf(bf16_t* p, f32x4 v) { u32x2 w; w.x = pk2(v[0], v[1]); w.y = pk2(v[2], v[3]); *(u32x2*)p = w; }

__device__ __forceinline__ void phase1(const Params& p, LAS unsigned char* lds) {
    unsigned char* ws = p.ws;
    const bf16_t* xbf = (const bf16_t*)p.out;
    const bf16_t* Wt = (const bf16_t*)(ws + OFF_WIN);
    bf16_t* zs = (bf16_t*)(ws + OFF_ZS); bf16_t* zb = (bf16_t*)(ws + OFF_ZB); bf16_t* zc = (bf16_t*)(ws + OFF_ZC);
    bf16_t* gates = (bf16_t*)(ws + OFF_GATES); bf16_t* kpr = (bf16_t*)(ws + OFF_KPR);
    const bool blocked = gridDim.x == 256;
    const int nunits = blocked ? 19 : ((NPAN - (int)blockIdx.x + (int)gridDim.x - 1) / (int)gridDim.x) * 19;
    for (int ui = 0; ui < nunits; ++ui) {
        int pm, pn;
        int npm, npn;
        if (blocked) { const int x = blockIdx.x & 7, li = blockIdx.x >> 3, u = 32 * ui + li, pg = u / (19 * PGRP), s = u % (19 * PGRP); pn = s / PGRP; pm = 32 * x + PGRP * pg + (s % PGRP);
                       const int u2 = u + 32, pg2 = u2 / (19 * PGRP), s2 = u2 % (19 * PGRP); npn = s2 / PGRP; npm = 32 * x + PGRP * pg2 + (s2 % PGRP); }
        else { pm = blockIdx.x + (ui / 19) * gridDim.x; pn = ui % 19; npm = blockIdx.x + ((ui + 1) / 19) * gridDim.x; npn = (ui + 1) % 19; }
        {
            const int brow = pm * 256;
            gemm_unit<true>(xbf, 1024, Wt, 1024, 1024, brow, pn * 256, lds, [&](f32x4 (&acc)[2][2][4][2], int wr, int wc, int fr, int fq) {
#pragma unroll
                for (int ai = 0; ai < 2; ++ai)
#pragma unroll
                    for (int m = 0; m < 4; ++m) {
                        const int row = brow + ai * 128 + wr * 64 + m * 16 + fr;
#pragma unroll
                        for (int bj = 0; bj < 2; ++bj) {
                                const int ct = bj * 128 + wc * 32 + fq * 8;
                                f32x4 v0 = acc[ai][bj][m][0], v1 = acc[ai][bj][m][1];
                                if (pn < 7) { const int c = pn * 256 + ct; store8bf(zs + (size_t)row * 1792 + c, v0, v1); if ((row & 255) == 255) store8bf(zb + (size_t)(row >> 8) * 1792 + c, v0, v1); }
                                else if (pn < 10) { const int c = (pn - 7) * 256 + ct; store8bf(zc + (size_t)row * 768 + c, v0, v1); }
                                else if (pn < 18) { const int c = (pn - 10) * 256 + ct;
#pragma unroll
                                    for (int j = 0; j < 4; ++j) { v0[j] = sigmoidf_(v0[j]); v1[j] = sigmoidf_(v1[j]); }
                                    store8bf(gates + (size_t)row * 2048 + c, v0, v1); }
                                else { if (ct < 32) store8bf(kpr + (size_t)row * 32 + ct, v0, v1); }
                            }
                    }
            }, ui > 0, ui + 1 < nunits, npm * 256, npn * 256);
        }
    }
}

__device__ __forceinline__ float red16(float x) {
    x += __builtin_bit_cast(float, __builtin_amdgcn_update_dpp(0, __builtin_bit_cast(int, x), 0xB1, 0xF, 0xF, true));
    x += __builtin_bit_cast(float, __builtin_amdgcn_update_dpp(0, __builtin_bit_cast(int, x), 0x4E, 0xF, 0xF, true));
    x += __builtin_bit_cast(float, __builtin_amdgcn_update_dpp(0, __builtin_bit_cast(int, x), 0x141, 0xF, 0xF, true));
    x += __builtin_bit_cast(float, __builtin_amdgcn_update_dpp(0, __builtin_bit_cast(int, x), 0x140, 0xF, 0xF, true));
    return x;
}

__device__ __forceinline__ void phase2(const Params& p, LAS unsigned char* lds) {
    unsigned char* ws = p.ws;
    bf16_t* zs = (bf16_t*)(ws + OFF_ZS); const bf16_t* zb = (const bf16_t*)(ws + OFF_ZB); const bf16_t* zc = (const bf16_t*)(ws + OFF_ZC);
    const bf16_t* kpr = (const bf16_t*)(ws + OFF_KPR);
    bf16_t* kkb = (bf16_t*)(ws + OFF_KK); bf16_t* bbb = (bf16_t*)(ws + OFF_BB); float* dec = (float*)(ws + OFF_DEC); bf16_t* gb = (bf16_t*)(ws + OFF_G);
    float* rstdq = (float*)(ws + OFF_RSTDQ); float* rstdkv = (float*)(ws + OFF_RSTDKV); float* bonus = (float*)(ws + OFF_BONUS);
    const float* ct = (const float*)(ws + OFF_ROPE); const float* st = ct + (size_t)T_TOK * 16;
    bf16_t* qo = (bf16_t*)((unsigned char*)p.out + DO_Q); bf16_t* kno = (bf16_t*)((unsigned char*)p.out + DO_KN);
    bf16_t* vto = (bf16_t*)((unsigned char*)p.out + DO_VT); bf16_t* kpeo = (bf16_t*)((unsigned char*)p.out + DO_KPE);
    const float* mu = p.in[3];
    for (int pm = blockIdx.x; pm < NPAN; pm += gridDim.x) {
        const int R0 = pm * 256;
        {
            const int tid = fresh_tid();
            const int half = tid / 224, ch = tid % 224, c0 = ch * 8, rs = R0 + half * 128;
            u32x4 pr = (u32x4){0u, 0u, 0u, 0u};
            if (tid < 448) {
                if (half == 0) { if ((pm & 15) != 0) pr = *(const u32x4*)(zb + (size_t)(pm - 1) * 1792 + c0); }
                else pr = *(const u32x4*)(zs + (size_t)(rs - 1) * 1792 + c0);
            }
            __syncthreads();
            if (tid < 448) {
                const f32x4 m0 = *(const f32x4*)(mu + c0), m1 = *(const f32x4*)(mu + c0 + 4);
                const int mode = (c0 >= 1536 && c0 < 1600) ? 1 : (c0 >= 1664 ? 2 : 0);
                for (int r0 = 0; r0 < 128; r0 += 8) {
                    u32x4 raw[8];
#pragma unroll
                    for (int j = 0; j < 8; ++j) raw[j] = *(const u32x4*)(zs + (size_t)(rs + r0 + j) * 1792 + c0);
#pragma unroll
                    for (int j = 0; j < 8; ++j) {
                        const u32x4 cu = raw[j];
                        float o[8];
                        o[0] = bflo(cu.x) + m0[0] * (bflo(pr.x) - bflo(cu.x)); o[1] = bfhi(cu.x) + m0[1] * (bfhi(pr.x) - bfhi(cu.x));
                        o[2] = bflo(cu.y) + m0[2] * (bflo(pr.y) - bflo(cu.y)); o[3] = bfhi(cu.y) + m0[3] * (bfhi(pr.y) - bfhi(cu.y));
                        o[4] = bflo(cu.z) + m1[0] * (bflo(pr.z) - bflo(cu.z)); o[5] = bfhi(cu.z) + m1[1] * (bfhi(pr.z) - bfhi(cu.z));
                        o[6] = bflo(cu.w) + m1[2] * (bflo(pr.w) - bflo(cu.w)); o[7] = bfhi(cu.w) + m1[3] * (bfhi(pr.w) - bfhi(cu.w));
                        if (mode == 1) {
#pragma unroll
                            for (int i = 0; i < 8; ++i) o[i] = tanhf_(o[i]);
                        } else if (mode == 2) {
#pragma unroll
                            for (int i = 0; i < 8; ++i) o[i] = sigmoidf_(o[i]);
                        }
                        u32x4 w; w.x = pk2(o[0], o[1]); w.y = pk2(o[2], o[3]); w.z = pk2(o[4], o[5]); w.w = pk2(o[6], o[7]);
                        *(u32x4*)(zs + (size_t)(rs + r0 + j) * 1792 + c0) = w;
                        pr = cu;
                    }
                }
            }
        }
        { const int tid = fresh_tid(), lane = tid & 63, wid = tid >> 6;
        for (int rr = 0; rr < 32; rr += 4) {
            u32x4 av[4], bv[4];
#pragma unroll
            for (int j = 0; j < 4; ++j) {
                const bf16_t* zr = zc + (size_t)(R0 + wid * 32 + rr + j) * 768;
                av[j] = *(const u32x4*)(zr + lane * 8);
                bv[j] = (u32x4){0u, 0u, 0u, 0u};
                if (lane < 32) bv[j] = *(const u32x4*)(zr + 512 + lane * 8);
            }
#pragma unroll
            for (int j = 0; j < 4; ++j) {
                const u32x4 a = av[j], b = bv[j];
                float sq = bflo(a.x) * bflo(a.x) + bfhi(a.x) * bfhi(a.x) + bflo(a.y) * bflo(a.y) + bfhi(a.y) * bfhi(a.y) + bflo(a.z) * bflo(a.z) + bfhi(a.z) * bfhi(a.z) + bflo(a.w) * bflo(a.w) + bfhi(a.w) * bfhi(a.w);
                float sk = bflo(b.x) * bflo(b.x) + bfhi(b.x) * bfhi(b.x) + bflo(b.y) * bflo(b.y) + bfhi(b.y) * bfhi(b.y) + bflo(b.z) * bflo(b.z) + bfhi(b.z) * bfhi(b.z) + bflo(b.w) * bflo(b.w) + bfhi(b.w) * bfhi(b.w);
#pragma unroll
                for (int o = 1; o < 64; o <<= 1) { sq += __shfl_xor(sq, o); sk += __shfl_xor(sk, o); }
                const int row = R0 + wid * 32 + rr + j;
                if (lane == 0) { rstdq[row] = rsqrtf(sq * (1.0f / 512.0f) + 1e-6f); rstdkv[row] = rsqrtf(sk * (1.0f / 256.0f) + 1e-6f); }
            }
        }
        }
        { const int tid = fresh_tid();
        {
            float x1[8], x2[8], cc[8], ss[8];
#pragma unroll
            for (int it = 0; it < 8; ++it) {
                const int idx = it * 512 + tid, row = R0 + (idx >> 4), i = idx & 15;
                x1[it] = bf1(kpr[(size_t)row * 32 + i]); x2[it] = bf1(kpr[(size_t)row * 32 + 16 + i]);
                cc[it] = ct[(size_t)row * 16 + i]; ss[it] = st[(size_t)row * 16 + i];
            }
#pragma unroll
            for (int it = 0; it < 8; ++it) {
                const int idx = it * 512 + tid, row = R0 + (idx >> 4), i = idx & 15;
                kpeo[(size_t)row * 32 + i] = (bf16_t)(pk2(x1[it] * cc[it] - x2[it] * ss[it], 0.f) & 0xffffu);
                kpeo[(size_t)row * 32 + 16 + i] = (bf16_t)(pk2(x2[it] * cc[it] + x1[it] * ss[it], 0.f) & 0xffffu);
            }
        }
        }
        for (int pn = 0; pn < 6; ++pn) {
            gemm_unit<true>(zs + 1536, 1792, (const bf16_t*)(ws + OFF_WLORA), 256, 256, R0, pn * 256, lds, [&](f32x4 (&acc)[2][2][4][2], int wr, int wc, int fr, int fq) {
#pragma unroll
                for (int bj = 0; bj < 2; ++bj) {
                        const int c = (pn & 1) * 256 + bj * 128 + wc * 32 + fq * 8;
                        f32x4 base0 = (f32x4){0.f, 0.f, 0.f, 0.f}, base1 = base0;
                        if (pn < 2) { base0 = *(const f32x4*)(p.in[5] + c); base1 = *(const f32x4*)(p.in[5] + c + 4); }
                        else if (pn < 4) { base0 = *(const f32x4*)(p.in[7] + c); base1 = *(const f32x4*)(p.in[7] + c + 4); }
#pragma unroll
                        for (int ai = 0; ai < 2; ++ai)
#pragma unroll
                            for (int m = 0; m < 4; ++m) {
                                const int row = R0 + ai * 128 + wr * 64 + m * 16 + fr;
                                f32x4 v0 = acc[ai][bj][m][0] + base0, v1 = acc[ai][bj][m][1] + base1;
                                if (pn < 2) {
#pragma unroll
                                    for (int j = 0; j < 4; ++j) { v0[j] = __expf(-0.6065306597126334f * sigmoidf_(v0[j])); v1[j] = __expf(-0.6065306597126334f * sigmoidf_(v1[j])); }
                                    *(f32x4*)(dec + (size_t)row * 512 + c) = v0; *(f32x4*)(dec + (size_t)row * 512 + c + 4) = v1;
                                } else if (pn < 4) {
#pragma unroll
                                    for (int j = 0; j < 4; ++j) { v0[j] = sigmoidf_(v0[j]); v1[j] = sigmoidf_(v1[j]); }
                                    store8bf(bbb + (size_t)row * 512 + c, v0, v1);
                                } else store8bf(gb + (size_t)row * 512 + c, v0, v1);
                            }
                    }
            }, pn > 0, pn + 1 < 6, R0, (pn + 1) * 256);
        }
        __syncthreads();
        { const int tid = fresh_tid();
        const int hd = (tid >> 4) & 7, l = tid & 15, c = hd * 64 + l * 4;
        const f32x4 kkp = *(const f32x4*)(p.in[9] + c), kap = *(const f32x4*)(p.in[10] + c), rkp = *(const f32x4*)(p.in[11] + c);
        for (int it0 = 0; it0 < 64; it0 += 4) {
            u32x2 zr2[4], zk2[4], a2[4];
#pragma unroll
            for (int j = 0; j < 4; ++j) {
                const int row = R0 + (((it0 + j) * 32 + (tid >> 4)) >> 3);
                const bf16_t* zrow = zs + (size_t)row * 1792;
                zr2[j] = *(const u32x2*)(zrow + c); zk2[j] = *(const u32x2*)(zrow + 512 + c); a2[j] = *(const u32x2*)(bbb + (size_t)row * 512 + c);
            }
#pragma unroll
            for (int j = 0; j < 4; ++j) {
                const int row = R0 + (((it0 + j) * 32 + (tid >> 4)) >> 3);
                bf16_t* zrow = zs + (size_t)row * 1792;
                float zr[4] = {bflo(zr2[j].x), bfhi(zr2[j].x), bflo(zr2[j].y), bfhi(zr2[j].y)};
                float zk[4] = {bflo(zk2[j].x), bfhi(zk2[j].x), bflo(zk2[j].y), bfhi(zk2[j].y)};
                float av[4] = {bflo(a2[j].x), bfhi(a2[j].x), bflo(a2[j].y), bfhi(a2[j].y)};
                float kv[4], km[4], ss = 0.f, bs = 0.f;
#pragma unroll
                for (int q = 0; q < 4; ++q) { kv[q] = zk[q] * kkp[q]; ss += kv[q] * kv[q]; km[q] = zk[q] * (1.0f + (av[q] - 1.0f) * kap[q]); bs += zr[q] * km[q] * rkp[q]; }
                ss = red16(ss); bs = red16(bs);
                const float inv = __builtin_amdgcn_rsqf(fmaxf(ss, 1e-24f));
                f32x4 kk4, b4, km4;
#pragma unroll
                for (int q = 0; q < 4; ++q) { kk4[q] = kv[q] * inv; b4[q] = kk4[q] * av[q]; km4[q] = km[q]; }
                store4bf(kkb + (size_t)row * 512 + c, kk4);
                store4bf(bbb + (size_t)row * 512 + c, b4);
                store4bf(zrow + 512 + c, km4);
                if (l == 0) bonus[(size_t)row * 8 + hd] = bs;
            }
        }
        }
        for (int pn = 0; pn < 3; ++pn) {
            gemm_unit<true>(zc, 768, (const bf16_t*)(ws + OFF_WUQ), 512, 512, R0, pn * 256, lds, [&](f32x4 (&acc)[2][2][4][2], int wr, int wc, int fr, int fq) {
#pragma unroll
                for (int ai = 0; ai < 2; ++ai)
#pragma unroll
                    for (int m = 0; m < 4; ++m) {
                        const int row = R0 + ai * 128 + wr * 64 + m * 16 + fr;
                        const float rs = rstdq[row] * QSCALE;
                        if (pn < 2) {
#pragma unroll
                            for (int bj = 0; bj < 2; ++bj) store8bf(qo + (size_t)row * 768 + pn * 256 + bj * 128 + wc * 32 + fq * 8, acc[ai][bj][m][0] * rs, acc[ai][bj][m][1] * rs);
                        } else {
                            const f32x4 cc = *(const f32x4*)(ct + (size_t)row * 16 + fq * 4), sn = *(const f32x4*)(st + (size_t)row * 16 + fq * 4);
#pragma unroll
                            for (int bj = 0; bj < 2; ++bj) {
                                const f32x4 x1 = acc[ai][bj][m][0] * rs, x2 = acc[ai][bj][m][1] * rs;
                                bf16_t* dst = qo + (size_t)row * 768 + 512 + (bj * 4 + wc) * 32 + fq * 4;
                                store4bf(dst, x1 * cc - x2 * sn);
                                store4bf(dst + 16, x2 * cc + x1 * sn);
                            }
                        }
                    }
            }, pn > 0, pn + 1 < 3, R0, (pn + 1) * 256);
        }
        for (int pn = 0; pn < 2; ++pn) {
            gemm_unit<true>(zc + 512, 768, (const bf16_t*)(ws + OFF_WUKV), 256, 256, R0, pn * 256, lds, [&](f32x4 (&acc)[2][2][4][2], int wr, int wc, int fr, int fq) {
#pragma unroll
                for (int ai = 0; ai < 2; ++ai)
#pragma unroll
                    for (int m = 0; m < 4; ++m) {
                        const int row = R0 + ai * 128 + wr * 64 + m * 16 + fr;
                        const float rs = rstdkv[row];
#pragma unroll
                        for (int bj = 0; bj < 2; ++bj) store8bf(kno + (size_t)row * 512 + pn * 256 + bj * 128 + wc * 32 + fq * 8, acc[ai][bj][m][0] * rs, acc[ai][bj][m][1] * rs);
                    }
            }, pn > 0, pn + 1 < 2, R0, (pn + 1) * 256);
        }
        for (int pn = 2; pn < 4; ++pn) {
            gemm_unit<false>(zc + 512, 768, (const bf16_t*)(ws + OFF_WUKV), 256, 256, R0, pn * 256, lds, [&](f32x4 (&acc)[2][2][4][2], int wr, int wc, int fr, int fq) {
                const int bb = R0 >> 12;
#pragma unroll
                for (int ai = 0; ai < 2; ++ai)
#pragma unroll
                    for (int m = 0; m < 4; ++m) {
                        const int row = R0 + ai * 128 + wr * 64 + m * 16 + fq * 4;
                        const f32x4 rs = *(const f32x4*)(rstdkv + row);
                        const int s0 = row & 4095;
#pragma unroll
                        for (int bj = 0; bj < 2; ++bj)
#pragma unroll
                            for (int n = 0; n < 2; ++n) {
                                const int c = (pn - 2) * 256 + bj * 128 + wc * 32 + n * 16 + fr, hd = c >> 6, d = c & 63;
                                store4bf(vto + ((size_t)((bb * 8 + hd) * 64 + d)) * 4096 + s0, acc[ai][bj][m][n] * rs);
                            }
                    }
            }, pn > 2, pn + 1 < 4, R0, (pn + 1) * 256);
        }
        __syncthreads();
    }
}

constexpr int SC_BUF = 45056, SC_YSM = 2 * SC_BUF;
__device__ __forceinline__ void scan_unit(const Params& p, int chain, int half, LAS unsigned char* lds) {
    unsigned char* ws = p.ws;
    const int tid = fresh_tid(), lane = tid & 63, wid = tid >> 6;
    const int b = chain >> 3, h = chain & 7, tb = b * SEQ, cb = h * 64;
    const bf16_t* zs = (const bf16_t*)(ws + OFF_ZS); const bf16_t* kkb = (const bf16_t*)(ws + OFF_KK); const bf16_t* bbb = (const bf16_t*)(ws + OFF_BB);
    const float* dec = (const float*)(ws + OFF_DEC); bf16_t* yo = (bf16_t*)(ws + OFF_Y);
    const int cA = tid & 255, stA = cA >> 3, colA = (cA & 7) * 8; const bool hiA = tid >= 256;
    const int stC = tid >> 4, colC = (tid & 15) * 4;
    const int stD = (tid & 127) >> 2, colD = (tid & 3) * 8;
    const bf16_t* srcA = zs + (size_t)(tb + stA) * 1792 + (hiA ? 512 : 0) + cb + colA;
    const bf16_t* srcB = (hiA ? bbb : kkb) + (size_t)(tb + stA) * 512 + cb + colA;
    const float* srcC = dec + (size_t)(tb + stC) * 512 + cb + colC;
    const bf16_t* srcD = zs + (size_t)(tb + stD) * 1792 + 1024 + cb + half * 32 + colD;
    const int ldA = (hiA ? 16384 : 0) + stA * 256 + colA * 4;
    const int ldB = (hiA ? 32768 : 24576) + stA * 256 + colA * 4;
    const int ldC = 8192 + stC * 256 + colC * 4;
    const int ldD = 40960 + stD * 128 + colD * 4;
    u32x4 ra, rb, rd = (u32x4){0u, 0u, 0u, 0u}; f32x4 rc;
    auto gload = [&](int blk) {
        ra = *(const u32x4*)(srcA + (size_t)blk * 32 * 1792);
        rb = *(const u32x4*)(srcB + (size_t)blk * 32 * 512);
        rc = *(const f32x4*)(srcC + (size_t)blk * 32 * 512);
        if (tid < 128) rd = *(const u32x4*)(srcD + (size_t)blk * 32 * 1792);
    };
    auto lstore = [&](int buf) {
        LAS unsigned char* base = lds + buf * SC_BUF;
        *(LAS f32x4*)(base + ldA) = (f32x4){bflo(ra.x), bfhi(ra.x), bflo(ra.y), bfhi(ra.y)};
        *(LAS f32x4*)(base + ldA + 16) = (f32x4){bflo(ra.z), bfhi(ra.z), bflo(ra.w), bfhi(ra.w)};
        *(LAS f32x4*)(base + ldB) = (f32x4){bflo(rb.x), bfhi(rb.x), bflo(rb.y), bfhi(rb.y)};
        *(LAS f32x4*)(base + ldB + 16) = (f32x4){bflo(rb.z), bfhi(rb.z), bflo(rb.w), bfhi(rb.w)};
        *(LAS f32x4*)(base + ldC) = rc;
        if (tid < 128) {
            *(LAS f32x4*)(base + ldD) = (f32x4){bflo(rd.x), bfhi(rd.x), bflo(rd.y), bfhi(rd.y)};
            *(LAS f32x4*)(base + ldD + 16) = (f32x4){bflo(rd.z), bfhi(rd.z), bflo(rd.w), bfhi(rd.w)};
        }
    };
    const int rg = lane >> 4, kq = lane & 15, wv = __builtin_amdgcn_readfirstlane(wid), myrow = wv * 8 + rg * 2;
    f32x2_t Sa01 = {0.f, 0.f}, Sa23 = {0.f, 0.f}, Sb01 = {0.f, 0.f}, Sb23 = {0.f, 0.f};
    bf16_t* ycol = yo + (size_t)tb * 512 + cb + half * 32 + myrow;
    __syncthreads();
    gload(0); lstore(0);
    __syncthreads();
    for (int blk = 0; blk < SEQ / 32; ++blk) {
        if (blk + 1 < SEQ / 32) gload(blk + 1);
        if (wv < 4) {
            LAS unsigned char* base = lds + (blk & 1) * SC_BUF;
            f32x4 nr4 = *(const LAS f32x4*)(base + kq * 16), nw4 = *(const LAS f32x4*)(base + 8192 + kq * 16), nk4 = *(const LAS f32x4*)(base + 16384 + kq * 16);
            f32x4 na4 = *(const LAS f32x4*)(base + 24576 + kq * 16), nb4 = *(const LAS f32x4*)(base + 32768 + kq * 16);
            f32x2_t nv2 = *(const LAS f32x2_t*)(base + 40960 + myrow * 4);
            for (int hq = 0; hq < 2; ++hq) {
            unsigned yacc = 0u;
#pragma unroll
            for (int j = 0; j < 16; ++j) {
                const f32x4 r4 = nr4, w4 = nw4, k4 = nk4, a4 = na4, b4 = nb4; const f32x2_t v2 = nv2;
                {
                    const int tn = (hq * 16 + j + 1) & 31;
                    nr4 = *(const LAS f32x4*)(base + tn * 256 + kq * 16); nw4 = *(const LAS f32x4*)(base + 8192 + tn * 256 + kq * 16); nk4 = *(const LAS f32x4*)(base + 16384 + tn * 256 + kq * 16);
                    na4 = *(const LAS f32x4*)(base + 24576 + tn * 256 + kq * 16); nb4 = *(const LAS f32x4*)(base + 32768 + tn * 256 + kq * 16);
                    nv2 = *(const LAS f32x2_t*)(base + 40960 + tn * 128 + myrow * 4);
                }
                __builtin_amdgcn_sched_barrier(0);
                const f32x2_t a01 = {a4[0], a4[1]}, a23 = {a4[2], a4[3]}, w01 = {w4[0], w4[1]}, w23 = {w4[2], w4[3]}, k01 = {k4[0], k4[1]}, k23 = {k4[2], k4[3]};
                const f32x2_t b01 = {b4[0], b4[1]}, b23 = {b4[2], b4[3]}, r01 = {r4[0], r4[1]}, r23 = {r4[2], r4[3]};
                f32x2_t ppa = Sa01 * a01; ppa = __builtin_elementwise_fma(Sa23, a23, ppa);
                f32x2_t ppb = Sb01 * a01; ppb = __builtin_elementwise_fma(Sb23, a23, ppb);
                const float pda = red16(ppa.x + ppa.y), pdb = red16(ppb.x + ppb.y);
                const f32x2_t npa = {-pda, -pda}, npb = {-pdb, -pdb}, va2 = {v2.x, v2.x}, vb2 = {v2.y, v2.y};
                Sa01 = __builtin_elementwise_fma(Sa01, w01, __builtin_elementwise_fma(npa, b01, va2 * k01));
                Sa23 = __builtin_elementwise_fma(Sa23, w23, __builtin_elementwise_fma(npa, b23, va2 * k23));
                Sb01 = __builtin_elementwise_fma(Sb01, w01, __builtin_elementwise_fma(npb, b01, vb2 * k01));
                Sb23 = __builtin_elementwise_fma(Sb23, w23, __builtin_elementwise_fma(npb, b23, vb2 * k23));
                f32x2_t yya = Sa01 * r01; yya = __builtin_elementwise_fma(Sa23, r23, yya);
                f32x2_t yyb = Sb01 * r01; yyb = __builtin_elementwise_fma(Sb23, r23, yyb);
                float ya0 = yya.x + yya.y, yb0 = yyb.x + yyb.y;
                asm volatile("" : "+v"(ya0)); asm volatile("" : "+v"(yb0));
                const float ya = red16(ya0), yb = red16(yb0);
                yacc = (kq == j) ? pk2(ya, yb) : yacc;
                __builtin_amdgcn_sched_barrier(0);
            }
            *(unsigned*)(ycol + (size_t)(blk * 32 + hq * 16 + kq) * 512) = yacc;
            }
        }
        if (blk + 1 < SEQ / 32) lstore((blk + 1) & 1);
        __syncthreads();
    }
}

constexpr int AT_KB = 13312, AT_VB = 8704, AT_V0 = 3 * AT_KB;
__device__ __forceinline__ void attn_unit(const Params& p, int b, int h, int qb, LAS unsigned char* lds) {
    const int tid = fresh_tid(), lane = tid & 63, wid = tid >> 6, r = lane & 31, hh = lane >> 5;
    const bf16_t* q = (const bf16_t*)((const unsigned char*)p.out + DO_Q); const bf16_t* kn = (const bf16_t*)((const unsigned char*)p.out + DO_KN);
    const bf16_t* vT = (const bf16_t*)((const unsigned char*)p.out + DO_VT); const bf16_t* kpe = (const bf16_t*)((const unsigned char*)p.out + DO_KPE);
    bf16_t* ym = (bf16_t*)(p.ws + OFF_ZC);
    const int tb = b * SEQ, q0w = qb * 256 + wid * 32;
    bf16x8 Q[6];
    {
        const bf16_t* qrow = q + (size_t)(tb + q0w + r) * 768;
#pragma unroll
        for (int s = 0; s < 4; ++s) Q[s] = *(const bf16x8*)(qrow + h * 64 + s * 16 + hh * 8);
#pragma unroll
        for (int s = 4; s < 6; ++s) Q[s] = *(const bf16x8*)(qrow + 512 + h * 32 + (s - 4) * 16 + hh * 8);
    }
    f32x16 O[2];
#pragma unroll
    for (int i = 0; i < 16; ++i) { O[0][i] = 0.f; O[1][i] = 0.f; }
    float mrun = -INFINITY, lrun = 0.f;
    const int nt = 4 * (qb + 1);
    const int id1 = tid + 512; const bool has1 = id1 < 768;
    const int row0 = tid / 12, c0 = tid % 12, row1 = has1 ? id1 / 12 : 0, c1 = has1 ? id1 % 12 : 0;
    const bf16_t* ks0 = (c0 < 8) ? kn + (size_t)(tb + row0) * 512 + h * 64 + c0 * 8 : kpe + (size_t)(tb + row0) * 32 + (c0 - 8) * 8;
    const int kst0 = (c0 < 8) ? 512 * 64 : 32 * 64;
    const bf16_t* ks1 = (c1 < 8) ? kn + (size_t)(tb + row1) * 512 + h * 64 + c1 * 8 : kpe + (size_t)(tb + row1) * 32 + (c1 - 8) * 8;
    const int kst1 = (c1 < 8) ? 512 * 64 : 32 * 64;
    const bf16_t* vs = vT + ((size_t)((b * 8 + h) * 64 + (tid >> 3))) * 4096 + (tid & 7) * 8;
    const int lk0 = row0 * 208 + c0 * 16, lk1 = row1 * 208 + c1 * 16, lv = (tid >> 3) * 136 + (tid & 7) * 16;
    u32x4 a0, a1 = (u32x4){0u, 0u, 0u, 0u}, av, b0, b1 = (u32x4){0u, 0u, 0u, 0u}, bv;
#define AT_GLOADK(G0, G1, kt) do { if ((kt) < nt) { G0 = *(const u32x4*)(ks0 + (size_t)(kt) * kst0); if (has1) G1 = *(const u32x4*)(ks1 + (size_t)(kt) * kst1); } } while (0)
#define AT_GLOADV(GV, kt) do { if ((kt) < nt) GV = *(const u32x4*)(vs + (kt) * 64); } while (0)
#define AT_LSTOREK(G0, G1, kt) do { if ((kt) < nt) { const int kb_ = ((kt) % 3) * AT_KB; *(LAS u32x4*)(lds + kb_ + lk0) = G0; if (has1) *(LAS u32x4*)(lds + kb_ + lk1) = G1; } } while (0)
#define AT_LSTOREV(GV, kt) do { if ((kt) < nt) { const int vb_ = AT_V0 + ((kt) & 1) * AT_VB; *(LAS u32x2*)(lds + vb_ + lv) = (u32x2){GV.x, GV.y}; *(LAS u32x2*)(lds + vb_ + lv + 8) = (u32x2){GV.z, GV.w}; } } while (0)
    const int wq = __builtin_amdgcn_readfirstlane(q0w);
    f32x16 Sc[2], Sn[2];
    auto qk = [&](f32x16 (&S)[2], int kt) {
        const LAS unsigned char* Kb = lds + (kt % 3) * AT_KB;
#pragma unroll
        for (int i = 0; i < 16; ++i) { S[0][i] = 0.f; S[1][i] = 0.f; }
#pragma unroll
        for (int s = 0; s < 6; ++s) {
            const bf16x8 K0 = *(const LAS bf16x8*)(Kb + r * 208 + s * 32 + hh * 16);
            const bf16x8 K1 = *(const LAS bf16x8*)(Kb + (32 + r) * 208 + s * 32 + hh * 16);
            S[0] = __builtin_amdgcn_mfma_f32_32x32x16_bf16(K0, Q[s], S[0], 0, 0, 0);
            S[1] = __builtin_amdgcn_mfma_f32_32x32x16_bf16(K1, Q[s], S[1], 0, 0, 0);
        }
    };
    auto step = [&](int kt) {
        if (kt * 64 > wq + 31) return;
        if (kt * 64 + 63 > wq) {
            const int qi = q0w + r;
#pragma unroll
            for (int kb = 0; kb < 2; ++kb)
#pragma unroll
                for (int i = 0; i < 16; ++i) { const int key = kt * 64 + kb * 32 + (i >> 2) * 8 + hh * 4 + (i & 3); if (key > qi) Sc[kb][i] = -INFINITY; }
        }
        const LAS unsigned char* Vb = lds + AT_V0 + (kt & 1) * AT_VB;
        float mx = Sc[0][0];
#pragma unroll
        for (int i = 1; i < 16; ++i) mx = fmaxf(mx, Sc[0][i]);
#pragma unroll
        for (int i = 0; i < 16; ++i) mx = fmaxf(mx, Sc[1][i]);
        mx = fmaxf(mx, __shfl_xor(mx, 32));
        const float mnew = fmaxf(mrun, mx);
        if (__builtin_amdgcn_ballot_w64(mnew != mrun) != 0ull) {
            const float alpha = __builtin_amdgcn_exp2f(mrun - mnew);
            lrun *= alpha;
#pragma unroll
            for (int i = 0; i < 16; ++i) { O[0][i] *= alpha; O[1][i] *= alpha; }
            mrun = mnew;
        }
        qk(Sn, kt + 1);
        float ls = 0.f;
#pragma unroll
        for (int kb = 0; kb < 2; ++kb)
#pragma unroll
            for (int i = 0; i < 16; ++i) { Sc[kb][i] = __builtin_amdgcn_exp2f(Sc[kb][i] - mnew); ls += Sc[kb][i]; }
        lrun += ls;
#pragma unroll
        for (int ks = 0; ks < 4; ++ks) {
            const int kb = ks >> 1, hf = ks & 1;
            u32x4 pw; pw.x = pk2(Sc[kb][hf * 8 + 0], Sc[kb][hf * 8 + 1]); pw.y = pk2(Sc[kb][hf * 8 + 2], Sc[kb][hf * 8 + 3]); pw.z = pk2(Sc[kb][hf * 8 + 4], Sc[kb][hf * 8 + 5]); pw.w = pk2(Sc[kb][hf * 8 + 6], Sc[kb][hf * 8 + 7]);
            const bf16x8 Pf = __builtin_bit_cast(bf16x8, pw);
#pragma unroll
            for (int db = 0; db < 2; ++db) {
                const LAS unsigned char* vp = Vb + (db * 32 + r) * 136 + (ks * 16 + hh * 4) * 2;
                const u32x2 va = *(const LAS u32x2*)vp, vb = *(const LAS u32x2*)(vp + 16);
                const bf16x8 Vf = __builtin_bit_cast(bf16x8, (u32x4){va.x, va.y, vb.x, vb.y});
                O[db] = __builtin_amdgcn_mfma_f32_32x32x16_bf16(Vf, Pf, O[db], 0, 0, 0);
            }
        }
        Sc[0] = Sn[0]; Sc[1] = Sn[1];
    };
    {
        u32x4 p0, p1 = (u32x4){0u, 0u, 0u, 0u};
        AT_GLOADK(p0, p1, 0);
        AT_GLOADK(a0, a1, 1); AT_GLOADV(av, 0);
        __syncthreads();
        AT_LSTOREK(p0, p1, 0);
        AT_LSTOREK(a0, a1, 1); AT_LSTOREV(av, 0);
        AT_GLOADK(b0, b1, 2); AT_GLOADV(bv, 1);
        __syncthreads();
    }
    qk(Sc, 0);
    for (int kt = 0; kt < nt; kt += 2) {
        AT_GLOADK(a0, a1, kt + 3); AT_GLOADV(av, kt + 2);
        step(kt);
        AT_LSTOREK(b0, b1, kt + 2); AT_LSTOREV(bv, kt + 1);
        __syncthreads();
        AT_GLOADK(b0, b1, kt + 4); AT_GLOADV(bv, kt + 3);
        step(kt + 1);
        AT_LSTOREK(a0, a1, kt + 3); AT_LSTOREV(av, kt + 2);
        __syncthreads();
    }
    lrun += __shfl_xor(lrun, 32);
    const float inv = __builtin_amdgcn_rcpf(lrun);
    bf16_t* orow = ym + (size_t)(tb + q0w + r) * 512 + h * 64;
#pragma unroll
    for (int db = 0; db < 2; ++db)
#pragma unroll
        for (int g = 0; g < 4; ++g) {
            f32x4 v = (f32x4){O[db][g * 4 + 0], O[db][g * 4 + 1], O[db][g * 4 + 2], O[db][g * 4 + 3]} * inv;
            store4bf(orow + db * 32 + g * 8 + hh * 4, v);
        }
}

constexpr int OV_AT = 2 * SC_BUF;
constexpr int OV_CTR = OV_AT + 3 * AT_KB + 2 * AT_VB;
__device__ __forceinline__ void bar4(LAS unsigned* ctr, unsigned& gen, int lane) {
    gen += 4u;
    asm volatile("s_waitcnt vmcnt(0) lgkmcnt(0)" ::: "memory");
    if (lane == 0) __hip_atomic_fetch_add((unsigned*)ctr, 1u, __ATOMIC_RELAXED, __HIP_MEMORY_SCOPE_WORKGROUP);
    while (true) {
        const unsigned v = __hip_atomic_load((unsigned*)ctr, __ATOMIC_RELAXED, __HIP_MEMORY_SCOPE_WORKGROUP);
        if ((int)(__builtin_amdgcn_readfirstlane(v) - gen) >= 0) break;
        __builtin_amdgcn_s_sleep(1);
    }
    asm volatile("s_waitcnt vmcnt(0) lgkmcnt(0)" ::: "memory");
}

__device__ __forceinline__ void scan_role(const Params& p, int chain, int half, LAS unsigned char* lds, LAS unsigned* ctr) {
    unsigned char* ws = p.ws;
    const int tid = fresh_tid(), lane = tid & 63, wid = tid >> 6;
    const int b = chain >> 3, h = chain & 7, tb = b * SEQ, cb = h * 64;
    const bf16_t* zs = (const bf16_t*)(ws + OFF_ZS); const bf16_t* kkb = (const bf16_t*)(ws + OFF_KK); const bf16_t* bbb = (const bf16_t*)(ws + OFF_BB);
    const float* dec = (const float*)(ws + OFF_DEC); bf16_t* yo = (bf16_t*)(ws + OFF_Y);
    const int stA = tid >> 3, colA = (tid & 7) * 8;
    const int stC0 = tid >> 4, colC = (tid & 15) * 4;
    const int stD = (tid & 127) >> 2, colD = (tid & 3) * 8;
    const bf16_t* srcR = zs + (size_t)(tb + stA) * 1792 + cb + colA;
    const bf16_t* srcK = srcR + 512;
    const bf16_t* srcKK = kkb + (size_t)(tb + stA) * 512 + cb + colA;
    const bf16_t* srcBB = bbb + (size_t)(tb + stA) * 512 + cb + colA;
    const float* srcW0 = dec + (size_t)(tb + stC0) * 512 + cb + colC;
    const float* srcW1 = srcW0 + (size_t)16 * 512;
    const bf16_t* srcV = zs + (size_t)(tb + stD) * 1792 + 1024 + cb + half * 32 + colD;
    const int ldR = stA * 256 + colA * 4, ldK = 16384 + ldR, ldKK = 24576 + ldR, ldBB = 32768 + ldR;
    const int ldW0 = 8192 + stC0 * 256 + colC * 4, ldW1 = ldW0 + 16 * 256;
    const int ldV = 40960 + stD * 128 + colD * 4;
    u32x4 rr, rk, rkk, rbb, rv = (u32x4){0u, 0u, 0u, 0u}; f32x4 rw0, rw1;
    auto gload = [&](int blk) {
        rr = *(const u32x4*)(srcR + (size_t)blk * 32 * 1792); rk = *(const u32x4*)(srcK + (size_t)blk * 32 * 1792);
        rkk = *(const u32x4*)(srcKK + (size_t)blk * 32 * 512); rbb = *(const u32x4*)(srcBB + (size_t)blk * 32 * 512);
        rw0 = *(const f32x4*)(srcW0 + (size_t)blk * 32 * 512); rw1 = *(const f32x4*)(srcW1 + (size_t)blk * 32 * 512);
        if (tid < 128) rv = *(const u32x4*)(srcV + (size_t)blk * 32 * 1792);
    };
    auto st8 = [&](LAS unsigned char* a, u32x4 x) {
        *(LAS f32x4*)a = (f32x4){bflo(x.x), bfhi(x.x), bflo(x.y), bfhi(x.y)};
        *(LAS f32x4*)(a + 16) = (f32x4){bflo(x.z), bfhi(x.z), bflo(x.w), bfhi(x.w)};
    };
    auto lstore = [&](int buf) {
        LAS unsigned char* base = lds + buf * SC_BUF;
        st8(base + ldR, rr); st8(base + ldK, rk); st8(base + ldKK, rkk); st8(base + ldBB, rbb);
        *(LAS f32x4*)(base + ldW0) = rw0; *(LAS f32x4*)(base + ldW1) = rw1;
        if (tid < 128) st8(base + ldV, rv);
    };
    const int rg = lane >> 4, kq = lane & 15, wv = __builtin_amdgcn_readfirstlane(wid), myrow = wv * 8 + rg * 2;
    f32x2_t Sa01 = {0.f, 0.f}, Sa23 = {0.f, 0.f}, Sb01 = {0.f, 0.f}, Sb23 = {0.f, 0.f};
    bf16_t* ycol = yo + (size_t)tb * 512 + cb + half * 32 + myrow;
    unsigned gen = 0u;
    gload(0); lstore(0);
    bar4(ctr, gen, lane);
    for (int blk = 0; blk < SEQ / 32; ++blk) {
        if (blk + 1 < SEQ / 32) gload(blk + 1);
        {
            LAS unsigned char* base = lds + (blk & 1) * SC_BUF;
            f32x4 nr4 = *(const LAS f32x4*)(base + kq * 16), nw4 = *(const LAS f32x4*)(base + 8192 + kq * 16), nk4 = *(const LAS f32x4*)(base + 16384 + kq * 16);
            f32x4 na4 = *(const LAS f32x4*)(base + 24576 + kq * 16), nb4 = *(const LAS f32x4*)(base + 32768 + kq * 16);
            f32x2_t nv2 = *(const LAS f32x2_t*)(base + 40960 + myrow * 4);
            for (int hq = 0; hq < 2; ++hq) {
            unsigned yacc = 0u;
#pragma unroll
            for (int j = 0; j < 16; ++j) {
                const f32x4 r4 = nr4, w4 = nw4, k4 = nk4, a4 = na4, b4 = nb4; const f32x2_t v2 = nv2;
                {
                    const int tn = (hq * 16 + j + 1) & 31;
                    nr4 = *(const LAS f32x4*)(base + tn * 256 + kq * 16); nw4 = *(const LAS f32x4*)(base + 8192 + tn * 256 + kq * 16); nk4 = *(const LAS f32x4*)(base + 16384 + tn * 256 + kq * 16);
                    na4 = *(const LAS f32x4*)(base + 24576 + tn * 256 + kq * 16); nb4 = *(const LAS f32x4*)(base + 32768 + tn * 256 + kq * 16);
                    nv2 = *(const LAS f32x2_t*)(base + 40960 + tn * 128 + myrow * 4);
                }
                __builtin_amdgcn_sched_barrier(0);
                const f32x2_t a01 = {a4[0], a4[1]}, a23 = {a4[2], a4[3]}, w01 = {w4[0], w4[1]}, w23 = {w4[2], w4[3]}, k01 = {k4[0], k4[1]}, k23 = {k4[2], k4[3]};
                const f32x2_t b01 = {b4[0], b4[1]}, b23 = {b4[2], b4[3]}, r01 = {r4[0], r4[1]}, r23 = {r4[2], r4[3]};
                f32x2_t ppa = Sa01 * a01; ppa = __builtin_elementwise_fma(Sa23, a23, ppa);
                f32x2_t ppb = Sb01 * a01; ppb = __builtin_elementwise_fma(Sb23, a23, ppb);
                const float pda = red16(ppa.x + ppa.y), pdb = red16(ppb.x + ppb.y);
                const f32x2_t npa = {-pda, -pda}, npb = {-pdb, -pdb}, va2 = {v2.x, v2.x}, vb2 = {v2.y, v2.y};
                Sa01 = __builtin_elementwise_fma(Sa01, w01, __builtin_elementwise_fma(npa, b01, va2 * k01));
                Sa23 = __builtin_elementwise_fma(Sa23, w23, __builtin_elementwise_fma(npa, b23, va2 * k23));
                Sb01 = __builtin_elementwise_fma(Sb01, w01, __builtin_elementwise_fma(npb, b01, vb2 * k01));
                Sb23 = __builtin_elementwise_fma(Sb23, w23, __builtin_elementwise_fma(npb, b23, vb2 * k23));
                f32x2_t yya = Sa01 * r01; yya = __builtin_elementwise_fma(Sa23, r23, yya);
                f32x2_t yyb = Sb01 * r01; yyb = __builtin_elementwise_fma(Sb23, r23, yyb);
                float ya0 = yya.x + yya.y, yb0 = yyb.x + yyb.y;
                asm volatile("" : "+v"(ya0)); asm volatile("" : "+v"(yb0));
                const float ya = red16(ya0), yb = red16(yb0);
                yacc = (kq == j) ? pk2(ya, yb) : yacc;
                __builtin_amdgcn_sched_barrier(0);
            }
            *(unsigned*)(ycol + (size_t)(blk * 32 + hq * 16 + kq) * 512) = yacc;
            }
        }
        if (blk + 1 < SEQ / 32) lstore((blk + 1) & 1);
        bar4(ctr, gen, lane);
    }
}

__device__ __forceinline__ void attn_role_unit(const Params& p, int b, int h, int qb, LAS unsigned char* lds, LAS unsigned* ctr, unsigned& gen) {
    const int tid = fresh_tid() - 256, lane = tid & 63, wid = tid >> 6, r = lane & 31, hh = lane >> 5;
    const bf16_t* q = (const bf16_t*)((const unsigned char*)p.out + DO_Q); const bf16_t* kn = (const bf16_t*)((const unsigned char*)p.out + DO_KN);
    const bf16_t* vT = (const bf16_t*)((const unsigned char*)p.out + DO_VT); const bf16_t* kpe = (const bf16_t*)((const unsigned char*)p.out + DO_KPE);
    bf16_t* ym = (bf16_t*)(p.ws + OFF_ZC);
    const int tb = b * SEQ, q0w = qb * 128 + wid * 32;
    bf16x8 Q[6];
    {
        const bf16_t* qrow = q + (size_t)(tb + q0w + r) * 768;
#pragma unroll
        for (int s = 0; s < 4; ++s) Q[s] = *(const bf16x8*)(qrow + h * 64 + s * 16 + hh * 8);
#pragma unroll
        for (int s = 4; s < 6; ++s) Q[s] = *(const bf16x8*)(qrow + 512 + h * 32 + (s - 4) * 16 + hh * 8);
    }
    f32x16 O[2];
#pragma unroll
    for (int i = 0; i < 16; ++i) { O[0][i] = 0.f; O[1][i] = 0.f; }
    float mrun = -INFINITY, lrun = 0.f;
    const int nt = 2 * (qb + 1);
    const bf16_t* ksrc[3]; int kstr[3], lk[3];
#pragma unroll
    for (int i = 0; i < 3; ++i) {
        const int id = tid + 256 * i, row = id / 12, c = id % 12;
        ksrc[i] = (c < 8) ? kn + (size_t)(tb + row) * 512 + h * 64 + c * 8 : kpe + (size_t)(tb + row) * 32 + (c - 8) * 8;
        kstr[i] = (c < 8) ? 512 * 64 : 32 * 64; lk[i] = row * 208 + c * 16;
    }
    const bf16_t* vsrc[2]; int lv[2];
#pragma unroll
    for (int i = 0; i < 2; ++i) { const int id = tid + 256 * i; vsrc[i] = vT + ((size_t)((b * 8 + h) * 64 + (id >> 3))) * 4096 + (id & 7) * 8; lv[i] = (id >> 3) * 136 + (id & 7) * 16; }
    u32x4 ak[3], av[2], bk[3], bv[2];
#define RV_GLOADK(G, kt) do { if ((kt) < nt) { _Pragma("unroll") for (int i_ = 0; i_ < 3; ++i_) G[i_] = *(const u32x4*)(ksrc[i_] + (size_t)(kt) * kstr[i_]); } } while (0)
#define RV_GLOADV(G, kt) do { if ((kt) < nt) { _Pragma("unroll") for (int i_ = 0; i_ < 2; ++i_) G[i_] = *(const u32x4*)(vsrc[i_] + (kt) * 64); } } while (0)
#define RV_LSTOREK(G, kt) do { if ((kt) < nt) { const int kb_ = ((kt) % 3) * AT_KB; _Pragma("unroll") for (int i_ = 0; i_ < 3; ++i_) *(LAS u32x4*)(lds + kb_ + lk[i_]) = G[i_]; } } while (0)
#define RV_LSTOREV(G, kt) do { if ((kt) < nt) { const int vb_ = AT_V0 + ((kt) & 1) * AT_VB; _Pragma("unroll") for (int i_ = 0; i_ < 2; ++i_) { \
        *(LAS u32x2*)(lds + vb_ + lv[i_]) = (u32x2){G[i_].x, G[i_].y}; *(LAS u32x2*)(lds + vb_ + lv[i_] + 8) = (u32x2){G[i_].z, G[i_].w}; } } } while (0)
    const int wq = __builtin_amdgcn_readfirstlane(q0w);
    f32x16 Sc[2], Sn[2];
    auto qk = [&](f32x16 (&S)[2], int kt) {
        const LAS unsigned char* Kb = lds + (kt % 3) * AT_KB;
#pragma unroll
        for (int i = 0; i < 16; ++i) { S[0][i] = 0.f; S[1][i] = 0.f; }
#pragma unroll
        for (int s = 0; s < 6; ++s) {
            const bf16x8 K0 = *(const LAS bf16x8*)(Kb + r * 208 + s * 32 + hh * 16);
            const bf16x8 K1 = *(const LAS bf16x8*)(Kb + (32 + r) * 208 + s * 32 + hh * 16);
            S[0] = __builtin_amdgcn_mfma_f32_32x32x16_bf16(K0, Q[s], S[0], 0, 0, 0);
            S[1] = __builtin_amdgcn_mfma_f32_32x32x16_bf16(K1, Q[s], S[1], 0, 0, 0);
        }
    };
    auto step = [&](int kt) {
        if (kt * 64 > wq + 31) return;
        if (kt * 64 + 63 > wq) {
            const int qi = q0w + r;
#pragma unroll
            for (int kb = 0; kb < 2; ++kb)
#pragma unroll
                for (int i = 0; i < 16; ++i) { const int key = kt * 64 + kb * 32 + (i >> 2) * 8 + hh * 4 + (i & 3); if (key > qi) Sc[kb][i] = -INFINITY; }
        }
        const LAS unsigned char* Vb = lds + AT_V0 + (kt & 1) * AT_VB;
        float mx = Sc[0][0];
#pragma unroll
        for (int i = 1; i < 16; ++i) mx = fmaxf(mx, Sc[0][i]);
#pragma unroll
        for (int i = 0; i < 16; ++i) mx = fmaxf(mx, Sc[1][i]);
        mx = fmaxf(mx, __shfl_xor(mx, 32));
        const float mnew = fmaxf(mrun, mx);
        if (__builtin_amdgcn_ballot_w64(mnew != mrun) != 0ull) {
            const float alpha = __builtin_amdgcn_exp2f(mrun - mnew);
            lrun *= alpha;
#pragma unroll
            for (int i = 0; i < 16; ++i) { O[0][i] *= alpha; O[1][i] *= alpha; }
            mrun = mnew;
        }
        qk(Sn, kt + 1);
        f32x2_t ls2 = {0.f, 0.f}; const f32x2_t mn2 = {mnew, mnew};
#pragma unroll
        for (int kb = 0; kb < 2; ++kb)
#pragma unroll
            for (int i = 0; i < 16; i += 2) {
                f32x2_t t = (f32x2_t){Sc[kb][i], Sc[kb][i + 1]} - mn2;
                t.x = __builtin_amdgcn_exp2f(t.x); t.y = __builtin_amdgcn_exp2f(t.y);
                ls2 += t; Sc[kb][i] = t.x; Sc[kb][i + 1] = t.y;
            }
        lrun += ls2.x + ls2.y;
#pragma unroll
        for (int ks = 0; ks < 4; ++ks) {
            const int kb = ks >> 1, hf = ks & 1;
            u32x4 pw; pw.x = pk2(Sc[kb][hf * 8 + 0], Sc[kb][hf * 8 + 1]); pw.y = pk2(Sc[kb][hf * 8 + 2], Sc[kb][hf * 8 + 3]); pw.z = pk2(Sc[kb][hf * 8 + 4], Sc[kb][hf * 8 + 5]); pw.w = pk2(Sc[kb][hf * 8 + 6], Sc[kb][hf * 8 + 7]);
            const bf16x8 Pf = __builtin_bit_cast(bf16x8, pw);
#pragma unroll
            for (int db = 0; db < 2; ++db) {
                const LAS unsigned char* vp = Vb + (db * 32 + r) * 136 + (ks * 16 + hh * 4) * 2;
                const u32x2 va = *(const LAS u32x2*)vp, vb = *(const LAS u32x2*)(vp + 16);
                const bf16x8 Vf = __builtin_bit_cast(bf16x8, (u32x4){va.x, va.y, vb.x, vb.y});
                O[db] = __builtin_amdgcn_mfma_f32_32x32x16_bf16(Vf, Pf, O[db], 0, 0, 0);
            }
        }
        Sc[0] = Sn[0]; Sc[1] = Sn[1];
    };
    {
        u32x4 pk0[3];
        RV_GLOADK(pk0, 0);
        RV_GLOADK(ak, 1); RV_GLOADV(av, 0);
        bar4(ctr, gen, lane);
        RV_LSTOREK(pk0, 0);
        RV_LSTOREK(ak, 1); RV_LSTOREV(av, 0);
        RV_GLOADK(bk, 2); RV_GLOADV(bv, 1);
        bar4(ctr, gen, lane);
    }
    qk(Sc, 0);
    for (int kt = 0; kt < nt; kt += 2) {
        RV_GLOADK(ak, kt + 3); RV_GLOADV(av, kt + 2);
        step(kt);
        RV_LSTOREK(bk, kt + 2); RV_LSTOREV(bv, kt + 1);
        bar4(ctr, gen, lane);
        RV_GLOADK(bk, kt + 4); RV_GLOADV(bv, kt + 3);
        step(kt + 1);
        RV_LSTOREK(ak, kt + 3); RV_LSTOREV(av, kt + 2);
        bar4(ctr, gen, lane);
    }
    lrun += __shfl_xor(lrun, 32);
    const float inv = __builtin_amdgcn_rcpf(lrun);
    bf16_t* orow = ym + (size_t)(tb + q0w + r) * 512 + h * 64;
#pragma unroll
    for (int db = 0; db < 2; ++db)
#pragma unroll
        for (int g = 0; g < 4; ++g) {
            f32x4 v = (f32x4){O[db][g * 4 + 0], O[db][g * 4 + 1], O[db][g * 4 + 2], O[db][g * 4 + 3]} * inv;
            store4bf(orow + db * 32 + g * 8 + hh * 4, v);
        }
}

__device__ __forceinline__ void phase3_overlap(const Params& p, LAS unsigned char* lds) {
    const int wv = __builtin_amdgcn_readfirstlane((int)threadIdx.x >> 6);
    LAS unsigned* ctr = (LAS unsigned*)(lds + OV_CTR);
    for (int u = blockIdx.x; u < 256; u += gridDim.x) {
        __syncthreads();
        if (threadIdx.x < 2) ctr[threadIdx.x] = 0u;
        __syncthreads();
        const int chain = u >> 1, half = u & 1, b = chain >> 3, h = chain & 7;
        if (wv < 4) {
            scan_role(p, chain, half, lds, ctr);
        } else {
            unsigned gen = 0u;
            for (int i = 0; i < 8; ++i) {
                const int qa = half * 8 + i;
                attn_role_unit(p, b, h, 31 - qa, lds + OV_AT, ctr + 1, gen);
                attn_role_unit(p, b, h, qa, lds + OV_AT, ctr + 1, gen);
            }
        }
    }
    __syncthreads();
}

__device__ __forceinline__ void phase3(const Params& p, LAS unsigned char* lds) {
#ifndef NO_SCAN
    for (int u = blockIdx.x; u < 256; u += gridDim.x) scan_unit(p, u >> 1, u & 1, lds);
#ifdef REP_SCAN
    for (int u = blockIdx.x; u < 256; u += gridDim.x) scan_unit(p, u >> 1, u & 1, lds);
#endif
#endif
#ifndef NO_ATTN
    for (int u = blockIdx.x; u < 256; u += gridDim.x) {
        const int chain = u >> 1, half = u & 1, b = chain >> 3, h = chain & 7;
        for (int i = 0; i < 4; ++i) {
            const int qa = half * 4 + i;
            attn_unit(p, b, h, 15 - qa, lds);
            attn_unit(p, b, h, qa, lds);
        }
    }
#endif
}

__device__ __forceinline__ void phase4(const Params& p, LAS unsigned char* lds) {
    unsigned char* ws = p.ws;
    bf16_t* yb = (bf16_t*)(ws + OFF_Y); const bf16_t* ymb = (const bf16_t*)(ws + OFF_ZC); const bf16_t* zs = (const bf16_t*)(ws + OFF_ZS);
    const bf16_t* gb = (const bf16_t*)(ws + OFF_G); const float* bonus = (const float*)(ws + OFF_BONUS); const bf16_t* gates = (const bf16_t*)(ws + OFF_GATES);
    bf16_t* merged = (bf16_t*)(ws + OFF_KK);
    for (int pm = blockIdx.x; pm < NPAN; pm += gridDim.x) {
        const int R0 = pm * 256;
        __syncthreads();
        const int tid = fresh_tid();
        const int hd = (tid >> 4) & 7, l = tid & 15, c = hd * 64 + l * 4;
        const f32x4 lg = *(const f32x4*)(p.in[12] + c), lb = *(const f32x4*)(p.in[13] + c);
        for (int it0 = 0; it0 < 64; it0 += 4) {
            u32x2 y2[4], v2[4], g2[4]; float bsv[4];
#pragma unroll
            for (int j = 0; j < 4; ++j) {
                const int row = R0 + (((it0 + j) * 32 + (tid >> 4)) >> 3);
                y2[j] = *(const u32x2*)(yb + (size_t)row * 512 + c); v2[j] = *(const u32x2*)(zs + (size_t)row * 1792 + 1024 + c); g2[j] = *(const u32x2*)(gb + (size_t)row * 512 + c);
                bsv[j] = bonus[(size_t)row * 8 + hd];
            }
#pragma unroll
            for (int j = 0; j < 4; ++j) {
                const int row = R0 + (((it0 + j) * 32 + (tid >> 4)) >> 3);
                float y[4] = {bflo(y2[j].x), bfhi(y2[j].x), bflo(y2[j].y), bfhi(y2[j].y)};
                const float vv[4] = {bflo(v2[j].x), bfhi(v2[j].x), bflo(v2[j].y), bfhi(v2[j].y)};
                const float gg[4] = {bflo(g2[j].x), bfhi(g2[j].x), bflo(g2[j].y), bfhi(g2[j].y)};
                float s = (y[0] + y[1]) + (y[2] + y[3]);
                s = red16(s);
                const float mean = s * (1.0f / 64.0f);
                float qv = 0.f;
#pragma unroll
                for (int q = 0; q < 4; ++q) { y[q] -= mean; qv += y[q] * y[q]; }
                qv = red16(qv);
                const float rstd = rsqrtf(qv * (1.0f / 64.0f) + 64e-5f);
                f32x4 o;
#pragma unroll
                for (int q = 0; q < 4; ++q) o[q] = (y[q] * rstd * lg[q] + lb[q] + bsv[j] * vv[q]) * gg[q];
                store4bf(yb + (size_t)row * 512 + c, o);
            }
        }
        __syncthreads();
        for (int pn = 0; pn < 4; ++pn) {
            gemm_unit<true>(yb, 512, (const bf16_t*)(ws + OFF_WPR), 512, 512, R0, pn * 256, lds, [&](f32x4 (&acc)[2][2][4][2], int wr, int wc, int fr, int fq) {
#pragma unroll
                for (int ai = 0; ai < 2; ++ai)
#pragma unroll
                    for (int m = 0; m < 4; ++m) {
                        const int row = R0 + ai * 128 + wr * 64 + m * 16 + fr;
#pragma unroll
                        for (int bj = 0; bj < 2; ++bj) {
                                const int c = pn * 256 + bj * 128 + wc * 32 + fq * 8;
                                const u32x4 g4 = *(const u32x4*)(gates + (size_t)row * 2048 + c);
                                const f32x4 gt0 = (f32x4){bflo(g4.x), bfhi(g4.x), bflo(g4.y), bfhi(g4.y)}, gt1 = (f32x4){bflo(g4.z), bfhi(g4.z), bflo(g4.w), bfhi(g4.w)};
                                store8bf(merged + (size_t)row * 1024 + c, acc[ai][bj][m][0] * gt0, acc[ai][bj][m][1] * gt1);
                            }
                    }
            }, pn > 0, pn + 1 < 4, R0, (pn + 1) * 256);
        }
        for (int pn = 0; pn < 4; ++pn) {
            gemm_unit<true>(ymb, 512, (const bf16_t*)(ws + OFF_WPM), 512, 512, R0, pn * 256, lds, [&](f32x4 (&acc)[2][2][4][2], int wr, int wc, int fr, int fq) {
#pragma unroll
                for (int ai = 0; ai < 2; ++ai)
#pragma unroll
                    for (int m = 0; m < 4; ++m) {
                        const int row = R0 + ai * 128 + wr * 64 + m * 16 + fr;
#pragma unroll
                        for (int bj = 0; bj < 2; ++bj) {
                                const int c = pn * 256 + bj * 128 + wc * 32 + fq * 8;
                                const u32x4 g4 = *(const u32x4*)(gates + (size_t)row * 2048 + 1024 + c);
                                const f32x4 gt0 = (f32x4){bflo(g4.x), bfhi(g4.x), bflo(g4.y), bfhi(g4.y)}, gt1 = (f32x4){bflo(g4.z), bfhi(g4.z), bflo(g4.w), bfhi(g4.w)};
                                const u32x4 p4 = *(const u32x4*)(merged + (size_t)row * 1024 + c);
                                const f32x4 pt0 = (f32x4){bflo(p4.x), bfhi(p4.x), bflo(p4.y), bfhi(p4.y)}, pt1 = (f32x4){bflo(p4.z), bfhi(p4.z), bflo(p4.w), bfhi(p4.w)};
                                store8bf(merged + (size_t)row * 1024 + c, pt0 + acc[ai][bj][m][0] * gt0, pt1 + acc[ai][bj][m][1] * gt1);
                            }
                    }
            }, pn > 0, pn + 1 < 4, R0, (pn + 1) * 256);
        }
    }
}

__device__ __forceinline__ void row_stats_acc(const f32x4 (&v)[2][2], LAS float* stat, int rloc, int fq) {
    float s = 0.f, q = 0.f;
#pragma unroll
    for (int bj = 0; bj < 2; ++bj)
#pragma unroll
        for (int n = 0; n < 2; ++n)
#pragma unroll
            for (int j = 0; j < 4; ++j) { s += v[bj][n][j]; q += v[bj][n][j] * v[bj][n][j]; }
    s += __shfl_xor(s, 16); s += __shfl_xor(s, 32); q += __shfl_xor(q, 16); q += __shfl_xor(q, 32);
    if (fq == 0) { atomicAdd((float*)(stat + rloc * 2), s); atomicAdd((float*)(stat + rloc * 2 + 1), q); }
}

template <int PART> __device__ __forceinline__ void phase5(const Params& p, LAS unsigned char* lds) {
    unsigned char* ws = p.ws;
    const bf16_t* merged = (const bf16_t*)(ws + OFF_KK); bf16_t* hbf = (bf16_t*)(ws + OFF_DEC); bf16_t* act = (bf16_t*)(ws + OFF_ACT);
    LAS float* stat = (LAS float*)(lds + 131072);
    const float* x = p.in[0];
    if (PART == 1) {
        const bool blocked = gridDim.x == 256;
        const int nunits = blocked ? 22 : ((NPAN - (int)blockIdx.x + (int)gridDim.x - 1) / (int)gridDim.x) * 22;
        for (int ui = 0; ui < nunits; ++ui) {
            int pm, pn;
            int npm, npn;
            if (blocked) { const int x = blockIdx.x & 7, li = blockIdx.x >> 3, u = 32 * ui + li, pg = u / (22 * PGRP), s = u % (22 * PGRP); pn = s / PGRP; pm = 32 * x + PGRP * pg + (s % PGRP);
                           const int u2 = u + 32, pg2 = u2 / (22 * PGRP), s2 = u2 % (22 * PGRP); npn = s2 / PGRP; npm = 32 * x + PGRP * pg2 + (s2 % PGRP); }
            else { pm = blockIdx.x + (ui / 22) * gridDim.x; pn = ui % 22; npm = blockIdx.x + ((ui + 1) / 22) * gridDim.x; npn = (ui + 1) % 22; }
            const int R0 = pm * 256;
            {
                {
                    gemm_unit<true>(hbf, 1024, (const bf16_t*)(ws + OFF_WGU), 1024, 1024, R0, pn * 256, lds, [&](f32x4 (&acc)[2][2][4][2], int wr, int wc, int fr, int fq) {
#pragma unroll
                        for (int ai = 0; ai < 2; ++ai)
#pragma unroll
                            for (int m = 0; m < 4; ++m) {
                                const int row = R0 + ai * 128 + wr * 64 + m * 16 + fr;
                                f32x4 o[2];
#pragma unroll
                                for (int n = 0; n < 2; ++n) {
                                    const f32x4 g = acc[ai][0][m][n], u = acc[ai][1][m][n];
#pragma unroll
                                    for (int j = 0; j < 4; ++j) o[n][j] = g[j] * sigmoidf_(g[j]) * u[j];
                                }
                                store8bf(act + (size_t)row * 2816 + pn * 128 + wc * 32 + fq * 8, o[0], o[1]);
                            }
                    }, ui > 0, ui + 1 < nunits, npm * 256, npn * 256);
                }
            }
        }
        return;
    }
    for (int pm = blockIdx.x; pm < NPAN; pm += gridDim.x) {
        const int R0 = pm * 256;
        {
            constexpr int stage = PART == 0 ? 0 : 1;
            __syncthreads();
            stat[fresh_tid()] = 0.f;
            __syncthreads();
            for (int pn = 0; pn < 4; ++pn) {
                const bf16_t* A = stage == 0 ? merged : act; const int lda = stage == 0 ? 1024 : 2816; const int K = lda;
                const bf16_t* Bt = (const bf16_t*)(ws + (stage == 0 ? OFF_WOUT : OFF_WD));
                const float* res = stage == 0 ? x : p.out;
                const float* mrs = (const float*)(ws + OFF_RSTDQ);
                gemm_unit<true>(A, lda, Bt, K, K, R0, pn * 256, lds, [&](f32x4 (&acc)[2][2][4][2], int wr, int wc, int fr, int fq) {
#pragma unroll
                    for (int ai = 0; ai < 2; ++ai)
#pragma unroll
                        for (int m = 0; m < 4; ++m) {
                            const int rloc = ai * 128 + wr * 64 + m * 16 + fr, row = R0 + rloc;
                            f32x4 v[2][2];
                            f32x2_t mr = {0.f, 1.f};
                            if (stage == 1) mr = *(const f32x2_t*)(mrs + (size_t)row * 2);
#pragma unroll
                            for (int bj = 0; bj < 2; ++bj)
#pragma unroll
                                for (int n = 0; n < 2; ++n) {
                                    const int col = pn * 256 + bj * 128 + wc * 32 + n * 16 + fq * 4;
                                    const size_t off = (size_t)row * 1024 + col;
                                    f32x4 rv = *(const f32x4*)(res + off);
                                    if (stage == 1) rv = (rv - mr.x) * mr.y * *(const f32x4*)(p.in[21] + col) + *(const f32x4*)(p.in[22] + col);
                                    v[bj][n] = rv * ALPHA_F + acc[ai][bj][m][n];
                                    *(f32x4*)(p.out + off) = v[bj][n];
                                }
                            row_stats_acc(v, stat, rloc, fq);
                        }
                }, pn > 0, pn + 1 < 4, R0, (pn + 1) * 256);
            }
            __syncthreads();
            const float* lg = p.in[stage == 0 ? 21 : 26]; const float* lb = p.in[stage == 0 ? 22 : 27];
            const int tid = fresh_tid(), lane = tid & 63, wid = tid >> 6;
            f32x4 gpar[4], bpar[4];
#pragma unroll
            for (int j = 0; j < 4; ++j) { gpar[j] = *(const f32x4*)(lg + j * 256 + lane * 4); bpar[j] = *(const f32x4*)(lb + j * 256 + lane * 4); }
            for (int rr = 0; rr < 32; rr += 2) {
                f32x4 v[2][4];
#pragma unroll
                for (int q = 0; q < 2; ++q)
#pragma unroll
                    for (int j = 0; j < 4; ++j) v[q][j] = *(const f32x4*)(p.out + (size_t)(R0 + wid * 32 + rr + q) * 1024 + j * 256 + lane * 4);
#pragma unroll
                for (int q = 0; q < 2; ++q) {
                    const int rloc = wid * 32 + rr + q, row = R0 + rloc;
                    const float mean = stat[rloc * 2] * (1.0f / 1024.0f);
                    const float var = fmaxf(stat[rloc * 2 + 1] * (1.0f / 1024.0f) - mean * mean, 0.f);
                    const float rstd = rsqrtf(var + 1e-5f);
                    float* orow = p.out + (size_t)row * 1024;
                    if (stage == 0 && lane == 0) *(f32x2_t*)((float*)(ws + OFF_RSTDQ) + (size_t)row * 2) = (f32x2_t){mean, rstd};
#pragma unroll
                    for (int j = 0; j < 4; ++j) {
                        const int c = j * 256 + lane * 4;
                        const f32x4 o = (v[q][j] - mean) * rstd * gpar[j] + bpar[j];
                        if (stage == 0) store4bf(hbf + (size_t)row * 1024 + c, o);
                        else *(f32x4*)(orow + c) = o;
                    }
                }
            }
        }
    }
}

#ifdef DBG
__device__ __forceinline__ void phase_dbg(const Params& p) {
    const size_t gt = (size_t)blockIdx.x * 512 + threadIdx.x, NT = (size_t)gridDim.x * 512;
    for (size_t i = gt; i < (size_t)T_TOK * 1024; i += NT) {
        const size_t t = i >> 10; const int c = (int)(i & 1023);
        float v;
#if DBG == 1
        v = bf1(((const bf16_t*)(p.ws + OFF_ZS))[t * 1792 + c]);
#elif DBG == 2
        v = c < 512 ? bf1(((const bf16_t*)(p.ws + OFF_KK))[t * 512 + c]) : bf1(((const bf16_t*)(p.ws + OFF_ZS))[t * 1792 + c]);
#elif DBG == 3
#if defined(NO_ATTN)
        v = bf1(((const bf16_t*)(p.ws + OFF_Y))[t * 512 + (c & 511)]);
#elif defined(NO_SCAN)
        v = bf1(((const bf16_t*)(p.ws + OFF_ZC))[t * 512 + (c & 511)]);
#else
        v = c < 512 ? bf1(((const bf16_t*)(p.ws + OFF_Y))[t * 512 + c]) : bf1(((const bf16_t*)(p.ws + OFF_ZC))[t * 512 + c - 512]);
#endif
#else
        v = bf1(((const bf16_t*)(p.ws + OFF_KK))[t * 1024 + c]);
#endif
        p.out[i] = v;
    }
}
#endif
__global__ void __launch_bounds__(512) mega_fwd(Params p) {
    extern __shared__ __attribute__((aligned(16))) unsigned char dyn_lds[];
    LAS unsigned char* lds = (LAS unsigned char*)dyn_lds;
    cg::grid_group grid = cg::this_grid();
    const int lo = p.ph_lo, hi = p.ph_hi;
    if (lo <= 0 && 0 < hi) phase0(p, lds);
    if (lo < 1 && 1 < hi) grid.sync();
    if (lo <= 1 && 1 < hi) phase1(p, lds);
#ifdef REP_P1
    grid.sync(); phase1(p, lds);
#endif
    if (lo < 2 && 2 < hi) grid.sync();
    if (lo <= 2 && 2 < hi) phase2(p, lds);
    if (lo < 3 && 3 < hi) grid.sync();
#if P3_OVERLAP
    if (lo <= 3 && 3 < hi) phase3_overlap(p, lds);
#else
    if (lo <= 3 && 3 < hi) phase3(p, lds);
#endif
#ifdef REP_P3
    grid.sync(); phase3(p, lds);
#endif
    if (lo < 4 && 4 < hi) grid.sync();
    if (lo <= 4 && 4 < hi) phase4(p, lds);
    if (lo < 5 && 5 < hi) __syncthreads();
    if (lo <= 5 && 5 < hi) phase5<0>(p, lds);
    if (lo < 6 && 6 < hi) grid.sync();
    if (lo <= 6 && 6 < hi) phase5<1>(p, lds);
    if (lo < 7 && 7 < hi) grid.sync();
    if (lo <= 7 && 7 < hi) phase5<2>(p, lds);
#ifdef DBG
    if (lo == 9) phase_dbg(p);
#endif
}


#ifndef N_LAUNCHES
#define N_LAUNCHES 1
#endif
extern "C" void kernel_launch(void* const* d_in, const int* in_sizes, int n_in, void* d_out, int out_size, void* d_ws, size_t ws_size, hipStream_t stream) {
    static int grid = 0;
    if (grid == 0) {
        int dev = 0, cus = 0, per_cu = 0;
        hipGetDevice(&dev);
        hipDeviceGetAttribute(&cus, hipDeviceAttributeMultiprocessorCount, dev);
        hipFuncSetAttribute((const void*)mega_fwd, hipFuncAttributeMaxDynamicSharedMemorySize, LDS_BYTES);
        hipOccupancyMaxActiveBlocksPerMultiprocessor(&per_cu, (const void*)mega_fwd, 512, LDS_BYTES);
        if (per_cu < 1) { fprintf(stderr, "kernel_launch: occupancy query says %d blocks/CU\n", per_cu); per_cu = 1; }
        grid = cus * 1;
        if (grid > 256) grid = 256;
        (void)hipGetLastError();
    }
    Params p{};
    for (int i = 0; i < 28; ++i) p.in[i] = (const float*)d_in[i];
    p.out = (float*)d_out; p.ws = (unsigned char*)d_ws;
#if N_LAUNCHES == 1
    p.ph_lo = 0; p.ph_hi = 8;
    void* args[] = {&p};
    hipError_t e = hipLaunchCooperativeKernel((const void*)mega_fwd, dim3(grid), dim3(512), args, LDS_BYTES, stream);
    if (e != hipSuccess) fprintf(stderr, "cooperative launch failed: %s (grid %d)\n", hipGetErrorString(e), grid);
#else
#ifdef DBG
    for (int ph = 0; ph <= DBG; ++ph) {
        p.ph_lo = ph; p.ph_hi = ph + 1;
        hipLaunchKernelGGL(mega_fwd, dim3(grid), dim3(512), LDS_BYTES, stream, p);
    }
    p.ph_lo = 9; p.ph_hi = 10;
    hipLaunchKernelGGL(mega_fwd, dim3(grid), dim3(512), LDS_BYTES, stream, p);
#else
    for (int ph = 0; ph < 8; ++ph) {
        p.ph_lo = ph; p.ph_hi = ph + 1;
        hipLaunchKernelGGL(mega_fwd, dim3(grid), dim3(512), LDS_BYTES, stream, p);
    }
#endif
#endif
}
```

```cpp
#include <hip/hip_runtime.h>
#include <hip/hip_cooperative_groups.h>
#include <cstdio>
#include <cstdint>
namespace cg = cooperative_groups;

#ifndef PGRP
#define PGRP 4
#endif
#ifndef P3_OVERLAP
#define P3_OVERLAP 1
#endif
#ifndef GEMM_8PHASE
#define GEMM_8PHASE 1
#endif
#define LAS __attribute__((address_space(3)))
typedef unsigned short bf16_t;
typedef short bf16x8 __attribute__((ext_vector_type(8)));
typedef float f32x4 __attribute__((ext_vector_type(4)));
typedef float f32x16 __attribute__((ext_vector_type(16)));
typedef unsigned u32x4 __attribute__((ext_vector_type(4)));
typedef unsigned u32x2 __attribute__((ext_vector_type(2)));

constexpr int T_TOK = 65536, SEQ = 4096, NPAN = 256;
constexpr size_t MiB = 1ull << 20;
constexpr size_t OFF_WIN = 0;
constexpr size_t OFF_WLORA = OFF_WIN + 4864ull * 1024 * 2;
constexpr size_t OFF_WUQ = OFF_WLORA + 1536ull * 256 * 2;
constexpr size_t OFF_WUKV = OFF_WUQ + 768ull * 512 * 2;
constexpr size_t OFF_WPR = OFF_WUKV + 1024ull * 256 * 2;
constexpr size_t OFF_WPM = OFF_WPR + 1024ull * 512 * 2;
constexpr size_t OFF_WOUT = OFF_WPM + 1024ull * 512 * 2;
constexpr size_t OFF_WGU = OFF_WOUT + 1024ull * 1024 * 2;
constexpr size_t OFF_WD = OFF_WGU + 5632ull * 1024 * 2;
constexpr size_t OFF_WEND = OFF_WD + 1024ull * 2816 * 2;
static_assert(OFF_WEND <= 34 * MiB, "weights region");
constexpr size_t OFF_ROPE = 34 * MiB;
constexpr size_t OFF_RSTDQ = 42 * MiB;
constexpr size_t OFF_RSTDKV = OFF_RSTDQ + 256 * 1024;
constexpr size_t OFF_BONUS = 43 * MiB;
constexpr size_t OFF_ZB = 45 * MiB;
constexpr size_t OFF_ZS = 48 * MiB;
constexpr size_t OFF_ZC = 272 * MiB;
constexpr size_t OFF_KPR = 368 * MiB;
constexpr size_t OFF_GATES = 372 * MiB;
constexpr size_t OFF_KK = 628 * MiB;
constexpr size_t OFF_BB = 692 * MiB;
constexpr size_t OFF_DEC = 756 * MiB;
constexpr size_t OFF_G = 884 * MiB;
constexpr size_t OFF_Y = 948 * MiB;
constexpr size_t OFF_ACT = 48 * MiB;
constexpr size_t DO_Q = 0, DO_KN = 96 * MiB, DO_VT = 160 * MiB, DO_KPE = 224 * MiB;

constexpr int LDS_BYTES = 147520;
constexpr float ALPHA_F = 1.189207115002721f;
constexpr float QSCALE = 0.10206207261596575f * 1.4426950408889634f;

struct Params { const float* in[28]; float* out; unsigned char* ws; int ph_lo, ph_hi; };

__device__ __constant__ float INVF[16] = {1.0f, 0.5623413251903491f, 0.31622776601683794f, 0.1778279410038923f,
                                          0.1f, 0.05623413251903491f, 0.031622776601683794f, 0.01778279410038923f,
                                          0.01f, 0.005623413251903491f, 0.0031622776601683794f, 0.001778279410038923f,
                                          0.001f, 0.0005623413251903491f, 0.00031622776601683794f, 0.0001778279410038923f};

typedef __bf16 bf16x2_t __attribute__((ext_vector_type(2)));
typedef float f32x2_t __attribute__((ext_vector_type(2)));
__device__ __forceinline__ unsigned pk2(float lo, float hi) { return __builtin_bit_cast(unsigned, __builtin_convertvector((f32x2_t){lo, hi}, bf16x2_t)); }
__device__ __forceinline__ float bflo(unsigned u) { return __uint_as_float(u << 16); }
__device__ __forceinline__ float bfhi(unsigned u) { return __uint_as_float(u & 0xffff0000u); }
__device__ __forceinline__ float bf1(bf16_t u) { return __uint_as_float(((unsigned)u) << 16); }
__device__ __forceinline__ float sigmoidf_(float x) { return __builtin_amdgcn_rcpf(1.0f + __expf(-x)); }
__device__ __forceinline__ float tanhf_(float x) { return 1.0f - 2.0f * __builtin_amdgcn_rcpf(1.0f + __expf(2.0f * x)); }
#define LDS_WAIT() asm volatile("s_waitcnt lgkmcnt(0)" ::: "memory")
__device__ __forceinline__ int fresh_tid() { int t = threadIdx.x; asm volatile("" : "+v"(t)); return t; }

constexpr int BM = 256, BK = 64, HALF = 128, HTB = HALF * BK * 2;
__device__ __forceinline__ int lds_byte(int r, int c) { const int st = (r >> 4) * 2 + (c >> 5), rr = r & 15, cc = c & 31, ob = rr * 64 + cc * 2; return st * 1024 + (ob ^ (((ob >> 9) & 1) << 5)); }
__device__ __forceinline__ void stage_rc(int b, int& R, int& C) { const int st = b / 1024, sb = b % 1024, swz = sb ^ (((sb >> 9) & 1) << 5); R = (st >> 1) * 16 + swz / 64; C = (st & 1) * 32 + (swz % 64) / 2; }

template <bool TR, typename Epi>
__device__ __forceinline__ void gemm_unit(const bf16_t* __restrict__ A, int lda, const bf16_t* __restrict__ Bt, int ldb, int K, int brow, int bcol, LAS unsigned char* lds, Epi epi,
                                          bool pre = false, bool nxt = false, int nbrow = 0, int nbcol = 0) {
    const int tid = fresh_tid(), wid = __builtin_amdgcn_readfirstlane(tid >> 6), lane = tid & 63, wr = wid >> 2, wc = wid & 3, fr = lane & 15, fq = lane >> 4;
    unsigned voffA[2], voffB[2];
#pragma unroll
    for (int i = 0; i < 2; ++i) { int r, c; stage_rc(tid * 16 + i * 8192, r, c); voffA[i] = (unsigned)(r * lda + c) * 2u; voffB[i] = (unsigned)(r * ldb + c) * 2u; }
    const bf16_t* Ab0 = A + (size_t)brow * lda; const bf16_t* Ab1 = Ab0 + (size_t)HALF * lda;
    const bf16_t* Bb0 = Bt + (size_t)bcol * ldb; const bf16_t* Bb1 = Bb0 + (size_t)HALF * ldb;
    const unsigned ldsw = (unsigned)wid * 1024u;
    const int aoff = lds_byte(wr * 64 + fr, fq * 8), boff = lds_byte(wc * 32 + fr, fq * 8);
#define G_SA(b, h) (((b) * 2 + (h)) * HTB)
#define G_SB(b, h) ((4 + (b) * 2 + (h)) * HTB)
#define G_STAGE(bufoff, gbase, voff, kt) do { const char* _gb = (const char*)((gbase) + (kt) * BK); _Pragma("unroll") for (int _i = 0; _i < 2; ++_i) \
        __builtin_amdgcn_global_load_lds((const unsigned*)(_gb + (voff)[_i]), (LAS unsigned*)(lds + (bufoff) + ldsw + _i * 8192), 16, 0, 0); } while (0)
#define G_LDA(dst, b, h) do { _Pragma("unroll") for (int m = 0; m < 4; ++m) _Pragma("unroll") for (int k = 0; k < 2; ++k) dst[m][k] = *(const LAS bf16x8*)(lds + G_SA(b, h) + aoff + m * 2048 + k * 1024); } while (0)
#define G_LDB(dst, b, h) do { _Pragma("unroll") for (int n = 0; n < 2; ++n) _Pragma("unroll") for (int k = 0; k < 2; ++k) dst[n][k] = *(const LAS bf16x8*)(lds + G_SB(b, h) + boff + n * 2048 + k * 1024); } while (0)
#define G_MMA(ai, bj, At_, Bt_) do { __builtin_amdgcn_s_setprio(1); _Pragma("unroll") for (int m = 0; m < 4; ++m) _Pragma("unroll") for (int n = 0; n < 2; ++n) _Pragma("unroll") for (int k = 0; k < 2; ++k) \
        acc[ai][bj][m][n] = TR ? __builtin_amdgcn_mfma_f32_16x16x32_bf16(Bt_[n][k], At_[m][k], acc[ai][bj][m][n], 0, 0, 0) \
                               : __builtin_amdgcn_mfma_f32_16x16x32_bf16(At_[m][k], Bt_[n][k], acc[ai][bj][m][n], 0, 0, 0); __builtin_amdgcn_s_setprio(0); } while (0)
#define G_WAIT_V(n) asm volatile("s_waitcnt vmcnt(" #n ")" ::: "memory")
#define G_WAIT_L(n) asm volatile("s_waitcnt lgkmcnt(" #n ")" ::: "memory")
#define G_BAR __builtin_amdgcn_s_barrier()
#define G_SCHED do { asm volatile("" ::: "memory"); __builtin_amdgcn_sched_barrier(0); } while (0)
    f32x4 acc[2][2][4][2];
#pragma unroll
    for (int a = 0; a < 2; ++a)
#pragma unroll
        for (int b = 0; b < 2; ++b)
#pragma unroll
            for (int m = 0; m < 4; ++m)
#pragma unroll
                for (int n = 0; n < 2; ++n) acc[a][b][m][n] = (f32x4){0.f, 0.f, 0.f, 0.f};
    bf16x8 At[4][2], B0[2][2], B1[2][2];
    const int nt = K / BK;
#if GEMM_8PHASE
    if (!pre) {
        asm volatile("s_waitcnt vmcnt(0) lgkmcnt(0)" ::: "memory");
        G_BAR;
        asm volatile("" ::: "memory");
        G_STAGE(G_SB(0, 0), Bb0, voffB, 0); G_STAGE(G_SA(0, 0), Ab0, voffA, 0);
        G_STAGE(G_SB(0, 1), Bb1, voffB, 0); G_STAGE(G_SA(0, 1), Ab1, voffA, 0);
        if (wr == 1) G_BAR;
        G_WAIT_V(4); G_BAR;
        G_STAGE(G_SB(1, 0), Bb0, voffB, 1); G_STAGE(G_SA(1, 0), Ab0, voffA, 1); G_STAGE(G_SB(1, 1), Bb1, voffB, 1);
        G_WAIT_V(6); G_BAR;
    }
    if (pre) { if (wr == 1) G_BAR; }
    const bf16_t* nA0 = nxt ? A + (size_t)nbrow * lda : Ab0; const bf16_t* nA1 = nA0 + (size_t)HALF * lda;
    const bf16_t* nB0 = nxt ? Bt + (size_t)nbcol * ldb : Bb0; const bf16_t* nB1 = nB0 + (size_t)HALF * ldb;
    for (int t = 0; t < nt; t += 2) {
        const bool last = (t == nt - 2);
        const bf16_t* pa0 = last ? nA0 : Ab0; const bf16_t* pa1 = last ? nA1 : Ab1; const bf16_t* pb0 = last ? nB0 : Bb0; const bf16_t* pb1 = last ? nB1 : Bb1;
        const int k2 = last ? 0 : t + 2, k3 = k2 + 1;
        G_LDB(B0, 0, 0); G_SCHED; G_LDA(At, 0, 0); G_STAGE(G_SA(1, 1), Ab1, voffA, t + 1);
        G_WAIT_L(8); G_BAR; G_WAIT_L(0); G_MMA(0, 0, At, B0); G_BAR; G_SCHED;
        G_LDB(B1, 0, 1); G_STAGE(G_SB(0, 0), pb0, voffB, k2);
        G_BAR; G_WAIT_L(0); G_MMA(0, 1, At, B1); G_BAR;
        G_LDA(At, 0, 1); G_STAGE(G_SA(0, 0), pa0, voffA, k2);
        G_BAR; G_WAIT_L(0); G_MMA(1, 0, At, B0); G_BAR; G_SCHED;
        G_STAGE(G_SB(0, 1), pb1, voffB, k2);
        G_WAIT_V(6); G_BAR; G_MMA(1, 1, At, B1); G_BAR;
        G_LDB(B0, 1, 0); G_SCHED; G_LDA(At, 1, 0); G_STAGE(G_SA(0, 1), pa1, voffA, k2);
        G_WAIT_L(8); G_BAR; G_WAIT_L(0); G_MMA(0, 0, At, B0); G_BAR; G_SCHED;
        G_LDB(B1, 1, 1); G_STAGE(G_SB(1, 0), pb0, voffB, k3);
        G_BAR; G_WAIT_L(0); G_MMA(0, 1, At, B1); G_BAR;
        G_LDA(At, 1, 1); G_STAGE(G_SA(1, 0), pa0, voffA, k3);
        G_BAR; G_WAIT_L(0); G_MMA(1, 0, At, B0); G_BAR; G_SCHED;
        G_STAGE(G_SB(1, 1), pb1, voffB, k3);
        G_WAIT_V(6); G_BAR; G_MMA(1, 1, At, B1); G_BAR;
    }
    if (!nxt) asm volatile("s_waitcnt vmcnt(0)" ::: "memory");
    if (wr == 0) G_BAR;
#else
    asm volatile("s_waitcnt vmcnt(0) lgkmcnt(0)" ::: "memory");
    G_BAR;
    asm volatile("" ::: "memory");
    G_STAGE(G_SB(0, 0), Bb0, voffB, 0); G_STAGE(G_SA(0, 0), Ab0, voffA, 0);
    G_STAGE(G_SB(0, 1), Bb1, voffB, 0); G_STAGE(G_SA(0, 1), Ab1, voffA, 0);
    for (int t = 0; t < nt; ++t) {
        G_WAIT_V(0); G_BAR;
        asm volatile("" ::: "memory");
        const int cb = (t & 1) * 2 * HTB, nb = cb ^ (2 * HTB);
        if (t + 1 < nt) { G_STAGE(4 * HTB + nb, Bb0, voffB, t + 1); G_STAGE(nb, Ab0, voffA, t + 1); G_STAGE(5 * HTB + nb, Bb1, voffB, t + 1); G_STAGE(HTB + nb, Ab1, voffA, t + 1); }
        LAS unsigned char* la = lds + cb + aoff; LAS unsigned char* lb = lds + 4 * HTB + cb + boff;
#define X_LDA(dst, h) do { _Pragma("unroll") for (int m = 0; m < 4; ++m) _Pragma("unroll") for (int k = 0; k < 2; ++k) dst[m][k] = *(const LAS bf16x8*)(la + (h) * HTB + m * 2048 + k * 1024); } while (0)
#define X_LDB(dst, h) do { _Pragma("unroll") for (int n = 0; n < 2; ++n) _Pragma("unroll") for (int k = 0; k < 2; ++k) dst[n][k] = *(const LAS bf16x8*)(lb + (h) * HTB + n * 2048 + k * 1024); } while (0)
        X_LDB(B0, 0); X_LDA(At, 0); X_LDB(B1, 1); G_SCHED; G_MMA(0, 0, At, B0); G_SCHED;
        G_MMA(0, 1, At, B1); G_SCHED;
        X_LDA(At, 1); G_SCHED; G_MMA(1, 0, At, B0); G_MMA(1, 1, At, B1); G_SCHED;
    }
#endif
    G_WAIT_L(0);
    asm volatile("" ::: "memory");
    { int fr_ = fr, fq_ = fq, wr_ = wr, wc_ = wc;
      asm volatile("" : "+v"(fr_), "+v"(fq_), "+v"(wr_), "+v"(wc_));
      epi(acc, wr_, wc_, fr_, fq_); }
}

__device__ __forceinline__ int perm32(int d) { return 8 * ((d >> 2) & 3) + 4 * (d >> 4) + (d & 3); }
__device__ __forceinline__ void wt_block(const float* src, int ldsrc, int col0, int ksrc0, const float* rowscale, bf16_t* dst, int Kdst, int n0, int k0, LAS float* scr, int lane, bool perm) {
#pragma unroll 8
    for (int i = 0; i < 32; ++i) {
        const int kk = 2 * i + (lane >> 5);
        float v = 0.f;
        if (src) { v = src[(size_t)(ksrc0 + kk) * ldsrc + col0 + (lane & 31)]; if (rowscale) v *= rowscale[ksrc0 + kk]; }
        scr[kk * 33 + (lane & 31)] = v;
    }
    LDS_WAIT();
    const int c = lane & 7;
#pragma unroll
    for (int j = 0; j < 4; ++j) {
        const int n = (lane >> 3) + 8 * j; const LAS float* s = scr + (8 * c) * 33 + (perm ? perm32(n) : n);
        u32x4 o; o.x = pk2(s[0 * 33], s[1 * 33]); o.y = pk2(s[2 * 33], s[3 * 33]); o.z = pk2(s[4 * 33], s[5 * 33]); o.w = pk2(s[6 * 33], s[7 * 33]);
        *(u32x4*)(dst + (size_t)(n0 + n) * Kdst + k0 + 8 * c) = o;
    }
    LDS_WAIT();
}

__device__ __forceinline__ void phase0(const Params& p, LAS unsigned char* lds) {
    const int tid = threadIdx.x, lane = tid & 63, wid = tid >> 6;
    const int gw = blockIdx.x * 8 + wid, NGW = gridDim.x * 8;
    LAS float* scr = (LAS float*)(lds + wid * 16384);
    unsigned char* ws = p.ws;
    for (int it = gw; it < 8192; it += NGW) {
        bool permw = false;
        int r = it; const float* src = nullptr; int ldsrc = 0, col0 = 0, ksrc0 = 0, Kd = 0, n0 = 0, k0 = 0; const float* rs = nullptr; bf16_t* dst = nullptr;
        if (r < 2432) { permw = true; const int nb = r % 152, kb = r / 152; n0 = nb * 32; k0 = kb * 64; Kd = 1024; dst = (bf16_t*)(ws + OFF_WIN); ldsrc = 4640; ksrc0 = k0;
            if (n0 < 2560) { src = p.in[2]; col0 = n0; } else if (n0 < 4608) { src = p.in[2]; col0 = n0 + 32; } else if (n0 < 4640) { src = p.in[2]; col0 = n0 - 4608 + 2560; } }
        else if ((r -= 2432) < 192) { permw = true; const int nb = r % 48, kb = r / 48; n0 = nb * 32; k0 = kb * 64; Kd = 256; dst = (bf16_t*)(ws + OFF_WLORA); ldsrc = 512;
            if (n0 < 512) { if (k0 == 0) { src = p.in[4]; col0 = n0; ksrc0 = 0; } }
            else if (n0 < 1024) { if (k0 == 64) { src = p.in[6]; col0 = n0 - 512; ksrc0 = 0; } }
            else { if (k0 >= 128) { src = p.in[8]; col0 = n0 - 1024; ksrc0 = k0 - 128; } } }
        else if ((r -= 192) < 192) { const int nb = r % 24, kb = r / 24; n0 = nb * 32; k0 = kb * 64; Kd = 512; dst = (bf16_t*)(ws + OFF_WUQ); ldsrc = 768; ksrc0 = k0; src = p.in[15]; rs = p.in[14];
            permw = n0 < 512;
            if (n0 < 512) col0 = (n0 >> 6) * 96 + (n0 & 63); else col0 = ((n0 - 512) >> 5) * 96 + 64; }
        else if ((r -= 192) < 128) { const int nb = r % 32, kb = r / 32; n0 = nb * 32; k0 = kb * 64; Kd = 256; dst = (bf16_t*)(ws + OFF_WUKV); ldsrc = 1024; ksrc0 = k0; src = p.in[17]; rs = p.in[16];
            permw = n0 < 512;
            if (n0 < 512) col0 = (n0 >> 6) * 128 + (n0 & 63); else col0 = ((n0 - 512) >> 6) * 128 + 64 + ((n0 - 512) & 63); }
        else if ((r -= 128) < 256) { permw = true; const int nb = r % 32, kb = r / 32; n0 = nb * 32; k0 = kb * 64; Kd = 512; dst = (bf16_t*)(ws + OFF_WPR); ldsrc = 1024; ksrc0 = k0; src = p.in[18]; col0 = n0; }
        else if ((r -= 256) < 256) { permw = true; const int nb = r % 32, kb = r / 32; n0 = nb * 32; k0 = kb * 64; Kd = 512; dst = (bf16_t*)(ws + OFF_WPM); ldsrc = 1024; ksrc0 = k0; src = p.in[19]; col0 = n0; }
        else if ((r -= 256) < 512) { const int nb = r % 32, kb = r / 32; n0 = nb * 32; k0 = kb * 64; Kd = 1024; dst = (bf16_t*)(ws + OFF_WOUT); ldsrc = 1024; ksrc0 = k0; src = p.in[20]; col0 = n0; }
        else if ((r -= 512) < 2816) { permw = true; const int nb = r % 176, kb = r / 176; n0 = nb * 32; k0 = kb * 64; Kd = 1024; dst = (bf16_t*)(ws + OFF_WGU); ldsrc = 2816; ksrc0 = k0;
            const int j = n0 >> 8, w = n0 & 255; if (w < 128) { src = p.in[23]; col0 = j * 128 + w; } else { src = p.in[24]; col0 = j * 128 + w - 128; } }
        else { r -= 2816; const int nb = r % 32, kb = r / 32; n0 = nb * 32; k0 = kb * 64; Kd = 2816; dst = (bf16_t*)(ws + OFF_WD); ldsrc = 1024; ksrc0 = k0; src = p.in[25]; col0 = n0; }
        wt_block(src, ldsrc, col0, ksrc0, rs, dst, Kd, n0, k0, scr, lane, permw);
    }
    {
        const size_t gt = (size_t)blockIdx.x * 512 + tid, NT = (size_t)gridDim.x * 512;
        const f32x4* x4 = (const f32x4*)p.in[0]; u32x4* o = (u32x4*)p.out;
        for (size_t i = gt; i < (size_t)T_TOK * 1024 / 8; i += NT) {
            const f32x4 a = x4[2 * i], b = x4[2 * i + 1];
            u32x4 w; w.x = pk2(a.x, a.y); w.y = pk2(a.z, a.w); w.z = pk2(b.x, b.y); w.w = pk2(b.z, b.w);
            o[i] = w;
        }
        const int* pos = (const int*)p.in[1];
        float* ct = (float*)(ws + OFF_ROPE); float* st = ct + (size_t)T_TOK * 16;
        for (size_t i = gt; i < (size_t)T_TOK * 16; i += NT) {
            const int t = (int)(i >> 4), f = (int)(i & 15);
            const float ang = (float)pos[t] * INVF[f];
            double rv = (double)ang * 0.15915494309189535; rv -= floor(rv);
            const float rf = (float)rv;
            ct[i] = __builtin_amdgcn_cosf(rf); st[i] = __builtin_amdgcn_sinf(rf);
        }
    }
}

__device__ __forceinline__ void store8bf(bf16_t* p, f32x4 a, f32x4 b) { u32x4 w; w.x = pk2(a[0], a[1]); w.y = pk2(a[2], a[3]); w.z = pk2(b[0], b[1]); w.w = pk2(b[2], b[3]); *(u32x4*)p = w; }
__device__ __forceinline__ void store4bf(bf16_t* p, f32x4 v) { u32x2 w; w.x = pk2(v[0], v[1]); w.y = pk2(v[2], v[3]); *(u32x2*)p = w; }

__device__ __forceinline__ void phase1(const Params& p, LAS unsigned char* lds) {
    unsigned char* ws = p.ws;
    const bf16_t* xbf = (const bf16_t*)p.out;
    const bf16_t* Wt = (const bf16_t*)(ws + OFF_WIN);
    bf16_t* zs = (bf16_t*)(ws + OFF_ZS); bf16_t* zb = (bf16_t*)(ws + OFF_ZB); bf16_t* zc = (bf16_t*)(ws + OFF_ZC);
    bf16_t* gates = (bf16_t*)(ws + OFF_GATES); bf16_t* kpr = (bf16_t*)(ws + OFF_KPR);
    const bool blocked = gridDim.x == 256;
    const int nunits = blocked ? 19 : ((NPAN - (int)blockIdx.x + (int)gridDim.x - 1) / (int)gridDim.x) * 19;
    for (int ui = 0; ui < nunits; ++ui) {
        int pm, pn;
        int npm, npn;
        if (blocked) { const int x = blockIdx.x & 7, li = blockIdx.x >> 3, u = 32 * ui + li, pg = u / (19 * PGRP), s = u % (19 * PGRP); pn = s / PGRP; pm = 32 * x + PGRP * pg + (s % PGRP);
                       const int u2 = u + 32, pg2 = u2 / (19 * PGRP), s2 = u2 % (19 * PGRP); npn = s2 / PGRP; npm = 32 * x + PGRP * pg2 + (s2 % PGRP); }
        else { pm = blockIdx.x + (ui / 19) * gridDim.x; pn = ui % 19; npm = blockIdx.x + ((ui + 1) / 19) * gridDim.x; npn = (ui + 1) % 19; }
        {
            const int brow = pm * 256;
            gemm_unit<true>(xbf, 1024, Wt, 1024, 1024, brow, pn * 256, lds, [&](f32x4 (&acc)[2][2][4][2], int wr, int wc, int fr, int fq) {
#pragma unroll
                for (int ai = 0; ai < 2; ++ai)
#pragma unroll
                    for (int m = 0; m < 4; ++m) {
                        const int row = brow + ai * 128 + wr * 64 + m * 16 + fr;
#pragma unroll
                        for (int bj = 0; bj < 2; ++bj) {
                                const int ct = bj * 128 + wc * 32 + fq * 8;
                                f32x4 v0 = acc[ai][bj][m][0], v1 = acc[ai][bj][m][1];
                                if (pn < 7) { const int c = pn * 256 + ct; store8bf(zs + (size_t)row * 1792 + c, v0, v1); if ((row & 255) == 255) store8bf(zb + (size_t)(row >> 8) * 1792 + c, v0, v1); }
                                else if (pn < 10) { const int c = (pn - 7) * 256 + ct; store8bf(zc + (size_t)row * 768 + c, v0, v1); }
                                else if (pn < 18) { const int c = (pn - 10) * 256 + ct;
#pragma unroll
                                    for (int j = 0; j < 4; ++j) { v0[j] = sigmoidf_(v0[j]); v1[j] = sigmoidf_(v1[j]); }
                                    store8bf(gates + (size_t)row * 2048 + c, v0, v1); }
                                else { if (ct < 32) store8bf(kpr + (size_t)row * 32 + ct, v0, v1); }
                            }
                    }
            }, ui > 0, ui + 1 < nunits, npm * 256, npn * 256);
        }
    }
}

__device__ __forceinline__ float red16(float x) {
    x += __builtin_bit_cast(float, __builtin_amdgcn_update_dpp(0, __builtin_bit_cast(int, x), 0xB1, 0xF, 0xF, true));
    x += __builtin_bit_cast(float, __builtin_amdgcn_update_dpp(0, __builtin_bit_cast(int, x), 0x4E, 0xF, 0xF, true));
    x += __builtin_bit_cast(float, __builtin_amdgcn_update_dpp(0, __builtin_bit_cast(int, x), 0x141, 0xF, 0xF, true));
    x += __builtin_bit_cast(float, __builtin_amdgcn_update_dpp(0, __builtin_bit_cast(int, x), 0x140, 0xF, 0xF, true));
    return x;
}

__device__ __forceinline__ void phase2(const Params& p, LAS unsigned char* lds) {
    unsigned char* ws = p.ws;
    bf16_t* zs = (bf16_t*)(ws + OFF_ZS); const bf16_t* zb = (const bf16_t*)(ws + OFF_ZB); const bf16_t* zc = (const bf16_t*)(ws + OFF_ZC);
    const bf16_t* kpr = (const bf16_t*)(ws + OFF_KPR);
    bf16_t* kkb = (bf16_t*)(ws + OFF_KK); bf16_t* bbb = (bf16_t*)(ws + OFF_BB); float* dec = (float*)(ws + OFF_DEC); bf16_t* gb = (bf16_t*)(ws + OFF_G);
    float* rstdq = (float*)(ws + OFF_RSTDQ); float* rstdkv = (float*)(ws + OFF_RSTDKV); float* bonus = (float*)(ws + OFF_BONUS);
    const float* ct = (const float*)(ws + OFF_ROPE); const float* st = ct + (size_t)T_TOK * 16;
    bf16_t* qo = (bf16_t*)((unsigned char*)p.out + DO_Q); bf16_t* kno = (bf16_t*)((unsigned char*)p.out + DO_KN);
    bf16_t* vto = (bf16_t*)((unsigned char*)p.out + DO_VT); bf16_t* kpeo = (bf16_t*)((unsigned char*)p.out + DO_KPE);
    const float* mu = p.in[3];
    for (int pm = blockIdx.x; pm < NPAN; pm += gridDim.x) {
        const int R0 = pm * 256;
        {
            const int tid = fresh_tid();
            const int half = tid / 224, ch = tid % 224, c0 = ch * 8, rs = R0 + half * 128;
            u32x4 pr = (u32x4){0u, 0u, 0u, 0u};
            if (tid < 448) {
                if (half == 0) { if ((pm & 15) != 0) pr = *(const u32x4*)(zb + (size_t)(pm - 1) * 1792 + c0); }
                else pr = *(const u32x4*)(zs + (size_t)(rs - 1) * 1792 + c0);
            }
            __syncthreads();
            if (tid < 448) {
                const f32x4 m0 = *(const f32x4*)(mu + c0), m1 = *(const f32x4*)(mu + c0 + 4);
                const int mode = (c0 >= 1536 && c0 < 1600) ? 1 : (c0 >= 1664 ? 2 : 0);
                for (int r0 = 0; r0 < 128; r0 += 8) {
                    u32x4 raw[8];
#pragma unroll
                    for (int j = 0; j < 8; ++j) raw[j] = *(const u32x4*)(zs + (size_t)(rs + r0 + j) * 1792 + c0);
#pragma unroll
                    for (int j = 0; j < 8; ++j) {
                        const u32x4 cu = raw[j];
                        float o[8];
                        o[0] = bflo(cu.x) + m0[0] * (bflo(pr.x) - bflo(cu.x)); o[1] = bfhi(cu.x) + m0[1] * (bfhi(pr.x) - bfhi(cu.x));
                        o[2] = bflo(cu.y) + m0[2] * (bflo(pr.y) - bflo(cu.y)); o[3] = bfhi(cu.y) + m0[3] * (bfhi(pr.y) - bfhi(cu.y));
                        o[4] = bflo(cu.z) + m1[0] * (bflo(pr.z) - bflo(cu.z)); o[5] = bfhi(cu.z) + m1[1] * (bfhi(pr.z) - bfhi(cu.z));
                        o[6] = bflo(cu.w) + m1[2] * (bflo(pr.w) - bflo(cu.w)); o[7] = bfhi(cu.w) + m1[3] * (bfhi(pr.w) - bfhi(cu.w));
                        if (mode == 1) {
#pragma unroll
                            for (int i = 0; i < 8; ++i) o[i] = tanhf_(o[i]);
                        } else if (mode == 2) {
#pragma unroll
                            for (int i = 0; i < 8; ++i) o[i] = sigmoidf_(o[i]);
                        }
                        u32x4 w; w.x = pk2(o[0], o[1]); w.y = pk2(o[2], o[3]); w.z = pk2(o[4], o[5]); w.w = pk2(o[6], o[7]);
                        *(u32x4*)(zs + (size_t)(rs + r0 + j) * 1792 + c0) = w;
                        pr = cu;
                    }
                }
            }
        }
        { const int tid = fresh_tid(), lane = tid & 63, wid = tid >> 6;
        for (int rr = 0; rr < 32; rr += 4) {
            u32x4 av[4], bv[4];
#pragma unroll
            for (int j = 0; j < 4; ++j) {
                const bf16_t* zr = zc + (size_t)(R0 + wid * 32 + rr + j) * 768;
                av[j] = *(const u32x4*)(zr + lane * 8);
                bv[j] = (u32x4){0u, 0u, 0u, 0u};
                if (lane < 32) bv[j] = *(const u32x4*)(zr + 512 + lane * 8);
            }
#pragma unroll
            for (int j = 0; j < 4; ++j) {
                const u32x4 a = av[j], b = bv[j];
                float sq = bflo(a.x) * bflo(a.x) + bfhi(a.x) * bfhi(a.x) + bflo(a.y) * bflo(a.y) + bfhi(a.y) * bfhi(a.y) + bflo(a.z) * bflo(a.z) + bfhi(a.z) * bfhi(a.z) + bflo(a.w) * bflo(a.w) + bfhi(a.w) * bfhi(a.w);
                float sk = bflo(b.x) * bflo(b.x) + bfhi(b.x) * bfhi(b.x) + bflo(b.y) * bflo(b.y) + bfhi(b.y) * bfhi(b.y) + bflo(b.z) * bflo(b.z) + bfhi(b.z) * bfhi(b.z) + bflo(b.w) * bflo(b.w) + bfhi(b.w) * bfhi(b.w);
#pragma unroll
                for (int o = 1; o < 64; o <<= 1) { sq += __shfl_xor(sq, o); sk += __shfl_xor(sk, o); }
                const int row = R0 + wid * 32 + rr + j;
                if (lane == 0) { rstdq[row] = rsqrtf(sq * (1.0f / 512.0f) + 1e-6f); rstdkv[row] = rsqrtf(sk * (1.0f / 256.0f) + 1e-6f); }
            }
        }
        }
        { const int tid = fresh_tid();
        {
            float x1[8], x2[8], cc[8], ss[8];
#pragma unroll
            for (int it = 0; it < 8; ++it) {
                const int idx = it * 512 + tid, row = R0 + (idx >> 4), i = idx & 15;
                x1[it] = bf1(kpr[(size_t)row * 32 + i]); x2[it] = bf1(kpr[(size_t)row * 32 + 16 + i]);
                cc[it] = ct[(size_t)row * 16 + i]; ss[it] = st[(size_t)row * 16 + i];
            }
#pragma unroll
            for (int it = 0; it < 8; ++it) {
                const int idx = it * 512 + tid, row = R0 + (idx >> 4), i = idx & 15;
                kpeo[(size_t)row * 32 + i] = (bf16_t)(pk2(x1[it] * cc[it] - x2[it] * ss[it], 0.f) & 0xffffu);
                kpeo[(size_t)row * 32 + 16 + i] = (bf16_t)(pk2(x2[it] * cc[it] + x1[it] * ss[it], 0.f) & 0xffffu);
            }
        }
        }
        for (int pn = 0; pn < 6; ++pn) {
            gemm_unit<true>(zs + 1536, 1792, (const bf16_t*)(ws + OFF_WLORA), 256, 256, R0, pn * 256, lds, [&](f32x4 (&acc)[2][2][4][2], int wr, int wc, int fr, int fq) {
#pragma unroll
                for (int bj = 0; bj < 2; ++bj) {
                        const int c = (pn & 1) * 256 + bj * 128 + wc * 32 + fq * 8;
                        f32x4 base0 = (f32x4){0.f, 0.f, 0.f, 0.f}, base1 = base0;
                        if (pn < 2) { base0 = *(const f32x4*)(p.in[5] + c); base1 = *(const f32x4*)(p.in[5] + c + 4); }
                        else if (pn < 4) { base0 = *(const f32x4*)(p.in[7] + c); base1 = *(const f32x4*)(p.in[7] + c + 4); }
#pragma unroll
                        for (int ai = 0; ai < 2; ++ai)
#pragma unroll
                            for (int m = 0; m < 4; ++m) {
                                const int row = R0 + ai * 128 + wr * 64 + m * 16 + fr;
                                f32x4 v0 = acc[ai][bj][m][0] + base0, v1 = acc[ai][bj][m][1] + base1;
                                if (pn < 2) {
#pragma unroll
                                    for (int j = 0; j < 4; ++j) { v0[j] = __expf(-0.6065306597126334f * sigmoidf_(v0[j])); v1[j] = __expf(-0.6065306597126334f * sigmoidf_(v1[j])); }
                                    *(f32x4*)(dec + (size_t)row * 512 + c) = v0; *(f32x4*)(dec + (size_t)row * 512 + c + 4) = v1;
                                } else if (pn < 4) {
#pragma unroll
                                    for (int j = 0; j < 4; ++j) { v0[j] = sigmoidf_(v0[j]); v1[j] = sigmoidf_(v1[j]); }
                                    store8bf(bbb + (size_t)row * 512 + c, v0, v1);
                                } else store8bf(gb + (size_t)row * 512 + c, v0, v1);
                            }
                    }
            }, pn > 0, pn + 1 < 6, R0, (pn + 1) * 256);
        }
        __syncthreads();
        { const int tid = fresh_tid();
        const int hd = (tid >> 4) & 7, l = tid & 15, c = hd * 64 + l * 4;
        const f32x4 kkp = *(const f32x4*)(p.in[9] + c), kap = *(const f32x4*)(p.in[10] + c), rkp = *(const f32x4*)(p.in[11] + c);
        for (int it0 = 0; it0 < 64; it0 += 4) {
            u32x2 zr2[4], zk2[4], a2[4];
#pragma unroll
            for (int j = 0; j < 4; ++j) {
                const int row = R0 + (((it0 + j) * 32 + (tid >> 4)) >> 3);
                const bf16_t* zrow = zs + (size_t)row * 1792;
                zr2[j] = *(const u32x2*)(zrow + c); zk2[j] = *(const u32x2*)(zrow + 512 + c); a2[j] = *(const u32x2*)(bbb + (size_t)row * 512 + c);
            }
#pragma unroll
            for (int j = 0; j < 4; ++j) {
                const int row = R0 + (((it0 + j) * 32 + (tid >> 4)) >> 3);
                bf16_t* zrow = zs + (size_t)row * 1792;
                float zr[4] = {bflo(zr2[j].x), bfhi(zr2[j].x), bflo(zr2[j].y), bfhi(zr2[j].y)};
                float zk[4] = {bflo(zk2[j].x), bfhi(zk2[j].x), bflo(zk2[j].y), bfhi(zk2[j].y)};
                float av[4] = {bflo(a2[j].x), bfhi(a2[j].x), bflo(a2[j].y), bfhi(a2[j].y)};
                float kv[4], km[4], ss = 0.f, bs = 0.f;
#pragma unroll
                for (int q = 0; q < 4; ++q) { kv[q] = zk[q] * kkp[q]; ss += kv[q] * kv[q]; km[q] = zk[q] * (1.0f + (av[q] - 1.0f) * kap[q]); bs += zr[q] * km[q] * rkp[q]; }
                ss = red16(ss); bs = red16(bs);
                const float inv = __builtin_amdgcn_rsqf(fmaxf(ss, 1e-24f));
                f32x4 kk4, b4, km4;
#pragma unroll
                for (int q = 0; q < 4; ++q) { kk4[q] = kv[q] * inv; b4[q] = kk4[q] * av[q]; km4[q] = km[q]; }
                store4bf(kkb + (size_t)row * 512 + c, kk4);
                store4bf(bbb + (size_t)row * 512 + c, b4);
                store4bf(zrow + 512 + c, km4);
                if (l == 0) bonus[(size_t)row * 8 + hd] = bs;
            }
        }
        }
        for (int pn = 0; pn < 3; ++pn) {
            gemm_unit<true>(zc, 768, (const bf16_t*)(ws + OFF_WUQ), 512, 512, R0, pn * 256, lds, [&](f32x4 (&acc)[2][2][4][2], int wr, int wc, int fr, int fq) {
#pragma unroll
                for (int ai = 0; ai < 2; ++ai)
#pragma unroll
                    for (int m = 0; m < 4; ++m) {
                        const int row = R0 + ai * 128 + wr * 64 + m * 16 + fr;
                        const float rs = rstdq[row] * QSCALE;
                        if (pn < 2) {
#pragma unroll
                            for (int bj = 0; bj < 2; ++bj) store8bf(qo + (size_t)row * 768 + pn * 256 + bj * 128 + wc * 32 + fq * 8, acc[ai][bj][m][0] * rs, acc[ai][bj][m][1] * rs);
                        } else {
                            const f32x4 cc = *(const f32x4*)(ct + (size_t)row * 16 + fq * 4), sn = *(const f32x4*)(st + (size_t)row * 16 + fq * 4);
#pragma unroll
                            for (int bj = 0; bj < 2; ++bj) {
                                const f32x4 x1 = acc[ai][bj][m][0] * rs, x2 = acc[ai][bj][m][1] * rs;
                                bf16_t* dst = qo + (size_t)row * 768 + 512 + (bj * 4 + wc) * 32 + fq * 4;
                                store4bf(dst, x1 * cc - x2 * sn);
                                store4bf(dst + 16, x2 * cc + x1 * sn);
                            }
                        }
                    }
            }, pn > 0, pn + 1 < 3, R0, (pn + 1) * 256);
        }
        for (int pn = 0; pn < 2; ++pn) {
            gemm_unit<true>(zc + 512, 768, (const bf16_t*)(ws + OFF_WUKV), 256, 256, R0, pn * 256, lds, [&](f32x4 (&acc)[2][2][4][2], int wr, int wc, int fr, int fq) {
#pragma unroll
                for (int ai = 0; ai < 2; ++ai)
#pragma unroll
                    for (int m = 0; m < 4; ++m) {
                        const int row = R0 + ai * 128 + wr * 64 + m * 16 + fr;
                        const float rs = rstdkv[row];
#pragma unroll
                        for (int bj = 0; bj < 2; ++bj) store8bf(kno + (size_t)row * 512 + pn * 256 + bj * 128 + wc * 32 + fq * 8, acc[ai][bj][m][0] * rs, acc[ai][bj][m][1] * rs);
                    }
            }, pn > 0, pn + 1 < 2, R0, (pn + 1) * 256);
        }
        for (int pn = 2; pn < 4; ++pn) {
            gemm_unit<false>(zc + 512, 768, (const bf16_t*)(ws + OFF_WUKV), 256, 256, R0, pn * 256, lds, [&](f32x4 (&acc)[2][2][4][2], int wr, int wc, int fr, int fq) {
                const int bb = R0 >> 12;
#pragma unroll
                for (int ai = 0; ai < 2; ++ai)
#pragma unroll
                    for (int m = 0; m < 4; ++m) {
                        const int row = R0 + ai * 128 + wr * 64 + m * 16 + fq * 4;
                        const f32x4 rs = *(const f32x4*)(rstdkv + row);
                        const int s0 = row & 4095;
#pragma unroll
                        for (int bj = 0; bj < 2; ++bj)
#pragma unroll
                            for (int n = 0; n < 2; ++n) {
                                const int c = (pn - 2) * 256 + bj * 128 + wc * 32 + n * 16 + fr, hd = c >> 6, d = c & 63;
                                store4bf(vto + ((size_t)((bb * 8 + hd) * 64 + d)) * 4096 + s0, acc[ai][bj][m][n] * rs);
                            }
                    }
            }, pn > 2, pn + 1 < 4, R0, (pn + 1) * 256);
        }
        __syncthreads();
    }
}

constexpr int SC_BUF = 45056, SC_YSM = 2 * SC_BUF;
__device__ __forceinline__ void scan_unit(const Params& p, int chain, int half, LAS unsigned char* lds) {
    unsigned char* ws = p.ws;
    const int tid = fresh_tid(), lane = tid & 63, wid = tid >> 6;
    const int b = chain >> 3, h = chain & 7, tb = b * SEQ, cb = h * 64;
    const bf16_t* zs = (const bf16_t*)(ws + OFF_ZS); const bf16_t* kkb = (const bf16_t*)(ws + OFF_KK); const bf16_t* bbb = (const bf16_t*)(ws + OFF_BB);
    const float* dec = (const float*)(ws + OFF_DEC); bf16_t* yo = (bf16_t*)(ws + OFF_Y);
    const int cA = tid & 255, stA = cA >> 3, colA = (cA & 7) * 8; const bool hiA = tid >= 256;
    const int stC = tid >> 4, colC = (tid & 15) * 4;
    const int stD = (tid & 127) >> 2, colD = (tid & 3) * 8;
    const bf16_t* srcA = zs + (size_t)(tb + stA) * 1792 + (hiA ? 512 : 0) + cb + colA;
    const bf16_t* srcB = (hiA ? bbb : kkb) + (size_t)(tb + stA) * 512 + cb + colA;
    const float* srcC = dec + (size_t)(tb + stC) * 512 + cb + colC;
    const bf16_t* srcD = zs + (size_t)(tb + stD) * 1792 + 1024 + cb + half * 32 + colD;
    const int ldA = (hiA ? 16384 : 0) + stA * 256 + colA * 4;
    const int ldB = (hiA ? 32768 : 24576) + stA * 256 + colA * 4;
    const int ldC = 8192 + stC * 256 + colC * 4;
    const int ldD = 40960 + stD * 128 + colD * 4;
    u32x4 ra, rb, rd = (u32x4){0u, 0u, 0u, 0u}; f32x4 rc;
    auto gload = [&](int blk) {
        ra = *(const u32x4*)(srcA + (size_t)blk * 32 * 1792);
        rb = *(const u32x4*)(srcB + (size_t)blk * 32 * 512);
        rc = *(const f32x4*)(srcC + (size_t)blk * 32 * 512);
        if (tid < 128) rd = *(const u32x4*)(srcD + (size_t)blk * 32 * 1792);
    };
    auto lstore = [&](int buf) {
        LAS unsigned char* base = lds + buf * SC_BUF;
        *(LAS f32x4*)(base + ldA) = (f32x4){bflo(ra.x), bfhi(ra.x), bflo(ra.y), bfhi(ra.y)};
        *(LAS f32x4*)(base + ldA + 16) = (f32x4){bflo(ra.z), bfhi(ra.z), bflo(ra.w), bfhi(ra.w)};
        *(LAS f32x4*)(base + ldB) = (f32x4){bflo(rb.x), bfhi(rb.x), bflo(rb.y), bfhi(rb.y)};
        *(LAS f32x4*)(base + ldB + 16) = (f32x4){bflo(rb.z), bfhi(rb.z), bflo(rb.w), bfhi(rb.w)};
        *(LAS f32x4*)(base + ldC) = rc;
        if (tid < 128) {
            *(LAS f32x4*)(base + ldD) = (f32x4){bflo(rd.x), bfhi(rd.x), bflo(rd.y), bfhi(rd.y)};
            *(LAS f32x4*)(base + ldD + 16) = (f32x4){bflo(rd.z), bfhi(rd.z), bflo(rd.w), bfhi(rd.w)};
        }
    };
    const int rg = lane >> 4, kq = lane & 15, wv = __builtin_amdgcn_readfirstlane(wid), myrow = wv * 8 + rg * 2;
    f32x2_t Sa01 = {0.f, 0.f}, Sa23 = {0.f, 0.f}, Sb01 = {0.f, 0.f}, Sb23 = {0.f, 0.f};
    bf16_t* ycol = yo + (size_t)tb * 512 + cb + half * 32 + myrow;
    __syncthreads();
    gload(0); lstore(0);
    __syncthreads();
    for (int blk = 0; blk < SEQ / 32; ++blk) {
        if (blk + 1 < SEQ / 32) gload(blk + 1);
        if (wv < 4) {
            LAS unsigned char* base = lds + (blk & 1) * SC_BUF;
            f32x4 nr4 = *(const LAS f32x4*)(base + kq * 16), nw4 = *(const LAS f32x4*)(base + 8192 + kq * 16), nk4 = *(const LAS f32x4*)(base + 16384 + kq * 16);
            f32x4 na4 = *(const LAS f32x4*)(base + 24576 + kq * 16), nb4 = *(const LAS f32x4*)(base + 32768 + kq * 16);
            f32x2_t nv2 = *(const LAS f32x2_t*)(base + 40960 + myrow * 4);
            for (int hq = 0; hq < 2; ++hq) {
            unsigned yacc = 0u;
#pragma unroll
            for (int j = 0; j < 16; ++j) {
                const f32x4 r4 = nr4, w4 = nw4, k4 = nk4, a4 = na4, b4 = nb4; const f32x2_t v2 = nv2;
                {
                    const int tn = (hq * 16 + j + 1) & 31;
                    nr4 = *(const LAS f32x4*)(base + tn * 256 + kq * 16); nw4 = *(const LAS f32x4*)(base + 8192 + tn * 256 + kq * 16); nk4 = *(const LAS f32x4*)(base + 16384 + tn * 256 + kq * 16);
                    na4 = *(const LAS f32x4*)(base + 24576 + tn * 256 + kq * 16); nb4 = *(const LAS f32x4*)(base + 32768 + tn * 256 + kq * 16);
                    nv2 = *(const LAS f32x2_t*)(base + 40960 + tn * 128 + myrow * 4);
                }
                __builtin_amdgcn_sched_barrier(0);
                const f32x2_t a01 = {a4[0], a4[1]}, a23 = {a4[2], a4[3]}, w01 = {w4[0], w4[1]}, w23 = {w4[2], w4[3]}, k01 = {k4[0], k4[1]}, k23 = {k4[2], k4[3]};
                const f32x2_t b01 = {b4[0], b4[1]}, b23 = {b4[2], b4[3]}, r01 = {r4[0], r4[1]}, r23 = {r4[2], r4[3]};
                f32x2_t ppa = Sa01 * a01; ppa = __builtin_elementwise_fma(Sa23, a23, ppa);
                f32x2_t ppb = Sb01 * a01; ppb = __builtin_elementwise_fma(Sb23, a23, ppb);
                const float pda = red16(ppa.x + ppa.y), pdb = red16(ppb.x + ppb.y);
                const f32x2_t npa = {-pda, -pda}, npb = {-pdb, -pdb}, va2 = {v2.x, v2.x}, vb2 = {v2.y, v2.y};
                Sa01 = __builtin_elementwise_fma(Sa01, w01, __builtin_elementwise_fma(npa, b01, va2 * k01));
                Sa23 = __builtin_elementwise_fma(Sa23, w23, __builtin_elementwise_fma(npa, b23, va2 * k23));
                Sb01 = __builtin_elementwise_fma(Sb01, w01, __builtin_elementwise_fma(npb, b01, vb2 * k01));
                Sb23 = __builtin_elementwise_fma(Sb23, w23, __builtin_elementwise_fma(npb, b23, vb2 * k23));
                f32x2_t yya = Sa01 * r01; yya = __builtin_elementwise_fma(Sa23, r23, yya);
                f32x2_t yyb = Sb01 * r01; yyb = __builtin_elementwise_fma(Sb23, r23, yyb);
                float ya0 = yya.x + yya.y, yb0 = yyb.x + yyb.y;
                asm volatile("" : "+v"(ya0)); asm volatile("" : "+v"(yb0));
                const float ya = red16(ya0), yb = red16(yb0);
                yacc = (kq == j) ? pk2(ya, yb) : yacc;
                __builtin_amdgcn_sched_barrier(0);
            }
            *(unsigned*)(ycol + (size_t)(blk * 32 + hq * 16 + kq) * 512) = yacc;
            }
        }
        if (blk + 1 < SEQ / 32) lstore((blk + 1) & 1);
        __syncthreads();
    }
}

constexpr int AT_KB = 13312, AT_VB = 8704, AT_V0 = 3 * AT_KB;
__device__ __forceinline__ void attn_unit(const Params& p, int b, int h, int qb, LAS unsigned char* lds) {
    const int tid = fresh_tid(), lane = tid & 63, wid = tid >> 6, r = lane & 31, hh = lane >> 5;
    const bf16_t* q = (const bf16_t*)((const unsigned char*)p.out + DO_Q); const bf16_t* kn = (const bf16_t*)((const unsigned char*)p.out + DO_KN);
    const bf16_t* vT = (const bf16_t*)((const unsigned char*)p.out + DO_VT); const bf16_t* kpe = (const bf16_t*)((const unsigned char*)p.out + DO_KPE);
    bf16_t* ym = (bf16_t*)(p.ws + OFF_ZC);
    const int tb = b * SEQ, q0w = qb * 256 + wid * 32;
    bf16x8 Q[6];
    {
        const bf16_t* qrow = q + (size_t)(tb + q0w + r) * 768;
#pragma unroll
        for (int s = 0; s < 4; ++s) Q[s] = *(const bf16x8*)(qrow + h * 64 + s * 16 + hh * 8);
#pragma unroll
        for (int s = 4; s < 6; ++s) Q[s] = *(const bf16x8*)(qrow + 512 + h * 32 + (s - 4) * 16 + hh * 8);
    }
    f32x16 O[2];
#pragma unroll
    for (int i = 0; i < 16; ++i) { O[0][i] = 0.f; O[1][i] = 0.f; }
    float mrun = -INFINITY, lrun = 0.f;
    const int nt = 4 * (qb + 1);
    const int id1 = tid + 512; const bool has1 = id1 < 768;
    const int row0 = tid / 12, c0 = tid % 12, row1 = has1 ? id1 / 12 : 0, c1 = has1 ? id1 % 12 : 0;
    const bf16_t* ks0 = (c0 < 8) ? kn + (size_t)(tb + row0) * 512 + h * 64 + c0 * 8 : kpe + (size_t)(tb + row0) * 32 + (c0 - 8) * 8;
    const int kst0 = (c0 < 8) ? 512 * 64 : 32 * 64;
    const bf16_t* ks1 = (c1 < 8) ? kn + (size_t)(tb + row1) * 512 + h * 64 + c1 * 8 : kpe + (size_t)(tb + row1) * 32 + (c1 - 8) * 8;
    const int kst1 = (c1 < 8) ? 512 * 64 : 32 * 64;
    const bf16_t* vs = vT + ((size_t)((b * 8 + h) * 64 + (tid >> 3))) * 4096 + (tid & 7) * 8;
    const int lk0 = row0 * 208 + c0 * 16, lk1 = row1 * 208 + c1 * 16, lv = (tid >> 3) * 136 + (tid & 7) * 16;
    u32x4 a0, a1 = (u32x4){0u, 0u, 0u, 0u}, av, b0, b1 = (u32x4){0u, 0u, 0u, 0u}, bv;
#define AT_GLOADK(G0, G1, kt) do { if ((kt) < nt) { G0 = *(const u32x4*)(ks0 + (size_t)(kt) * kst0); if (has1) G1 = *(const u32x4*)(ks1 + (size_t)(kt) * kst1); } } while (0)
#define AT_GLOADV(GV, kt) do { if ((kt) < nt) GV = *(const u32x4*)(vs + (kt) * 64); } while (0)
#define AT_LSTOREK(G0, G1, kt) do { if ((kt) < nt) { const int kb_ = ((kt) % 3) * AT_KB; *(LAS u32x4*)(lds + kb_ + lk0) = G0; if (has1) *(LAS u32x4*)(lds + kb_ + lk1) = G1; } } while (0)
#define AT_LSTOREV(GV, kt) do { if ((kt) < nt) { const int vb_ = AT_V0 + ((kt) & 1) * AT_VB; *(LAS u32x2*)(lds + vb_ + lv) = (u32x2){GV.x, GV.y}; *(LAS u32x2*)(lds + vb_ + lv + 8) = (u32x2){GV.z, GV.w}; } } while (0)
    const int wq = __builtin_amdgcn_readfirstlane(q0w);
    f32x16 Sc[2], Sn[2];
    auto qk = [&](f32x16 (&S)[2], int kt) {
        const LAS unsigned char* Kb = lds + (kt % 3) * AT_KB;
#pragma unroll
        for (int i = 0; i < 16; ++i) { S[0][i] = 0.f; S[1][i] = 0.f; }
#pragma unroll
        for (int s = 0; s < 6; ++s) {
            const bf16x8 K0 = *(const LAS bf16x8*)(Kb + r * 208 + s * 32 + hh * 16);
            const bf16x8 K1 = *(const LAS bf16x8*)(Kb + (32 + r) * 208 + s * 32 + hh * 16);
            S[0] = __builtin_amdgcn_mfma_f32_32x32x16_bf16(K0, Q[s], S[0], 0, 0, 0);
            S[1] = __builtin_amdgcn_mfma_f32_32x32x16_bf16(K1, Q[s], S[1], 0, 0, 0);
        }
    };
    auto step = [&](int kt) {
        if (kt * 64 > wq + 31) return;
        if (kt * 64 + 63 > wq) {
            const int qi = q0w + r;
#pragma unroll
            for (int kb = 0; kb < 2; ++kb)
#pragma unroll
                for (int i = 0; i < 16; ++i) { const int key = kt * 64 + kb * 32 + (i >> 2) * 8 + hh * 4 + (i & 3); if (key > qi) Sc[kb][i] = -INFINITY; }
        }
        const LAS unsigned char* Vb = lds + AT_V0 + (kt & 1) * AT_VB;
        float mx = Sc[0][0];
#pragma unroll
        for (int i = 1; i < 16; ++i) mx = fmaxf(mx, Sc[0][i]);
#pragma unroll
        for (int i = 0; i < 16; ++i) mx = fmaxf(mx, Sc[1][i]);
        mx = fmaxf(mx, __shfl_xor(mx, 32));
        const float mnew = fmaxf(mrun, mx);
        if (__builtin_amdgcn_ballot_w64(mnew != mrun) != 0ull) {
            const float alpha = __builtin_amdgcn_exp2f(mrun - mnew);
            lrun *= alpha;
#pragma unroll
            for (int i = 0; i < 16; ++i) { O[0][i] *= alpha; O[1][i] *= alpha; }
            mrun = mnew;
        }
        qk(Sn, kt + 1);
        float ls = 0.f;
#pragma unroll
        for (int kb = 0; kb < 2; ++kb)
#pragma unroll
            for (int i = 0; i < 16; ++i) { Sc[kb][i] = __builtin_amdgcn_exp2f(Sc[kb][i] - mnew); ls += Sc[kb][i]; }
        lrun += ls;
#pragma unroll
        for (int ks = 0; ks < 4; ++ks) {
            const int kb = ks >> 1, hf = ks & 1;
            u32x4 pw; pw.x = pk2(Sc[kb][hf * 8 + 0], Sc[kb][hf * 8 + 1]); pw.y = pk2(Sc[kb][hf * 8 + 2], Sc[kb][hf * 8 + 3]); pw.z = pk2(Sc[kb][hf * 8 + 4], Sc[kb][hf * 8 + 5]); pw.w = pk2(Sc[kb][hf * 8 + 6], Sc[kb][hf * 8 + 7]);
            const bf16x8 Pf = __builtin_bit_cast(bf16x8, pw);
#pragma unroll
            for (int db = 0; db < 2; ++db) {
                const LAS unsigned char* vp = Vb + (db * 32 + r) * 136 + (ks * 16 + hh * 4) * 2;
                const u32x2 va = *(const LAS u32x2*)vp, vb = *(const LAS u32x2*)(vp + 16);
                const bf16x8 Vf = __builtin_bit_cast(bf16x8, (u32x4){va.x, va.y, vb.x, vb.y});
                O[db] = __builtin_amdgcn_mfma_f32_32x32x16_bf16(Vf, Pf, O[db], 0, 0, 0);
            }
        }
        Sc[0] = Sn[0]; Sc[1] = Sn[1];
    };
    {
        u32x4 p0, p1 = (u32x4){0u, 0u, 0u, 0u};
        AT_GLOADK(p0, p1, 0);
        AT_GLOADK(a0, a1, 1); AT_GLOADV(av, 0);
        __syncthreads();
        AT_LSTOREK(p0, p1, 0);
        AT_LSTOREK(a0, a1, 1); AT_LSTOREV(av, 0);
        AT_GLOADK(b0, b1, 2); AT_GLOADV(bv, 1);
        __syncthreads();
    }
    qk(Sc, 0);
    for (int kt = 0; kt < nt; kt += 2) {
        AT_GLOADK(a0, a1, kt + 3); AT_GLOADV(av, kt + 2);
        step(kt);
        AT_LSTOREK(b0, b1, kt + 2); AT_LSTOREV(bv, kt + 1);
        __syncthreads();
        AT_GLOADK(b0, b1, kt + 4); AT_GLOADV(bv, kt + 3);
        step(kt + 1);
        AT_LSTOREK(a0, a1, kt + 3); AT_LSTOREV(av, kt + 2);
        __syncthreads();
    }
    lrun += __shfl_xor(lrun, 32);
    const float inv = __builtin_amdgcn_rcpf(lrun);
    bf16_t* orow = ym + (size_t)(tb + q0w + r) * 512 + h * 64;
#pragma unroll
    for (int db = 0; db < 2; ++db)
#pragma unroll
        for (int g = 0; g < 4; ++g) {
            f32x4 v = (f32x4){O[db][g * 4 + 0], O[db][g * 4 + 1], O[db][g * 4 + 2], O[db][g * 4 + 3]} * inv;
            store4bf(orow + db * 32 + g * 8 + hh * 4, v);
        }
}

constexpr int OV_AT = 2 * SC_BUF;
constexpr int OV_CTR = OV_AT + 3 * AT_KB + 2 * AT_VB;
__device__ __forceinline__ void bar4(LAS unsigned* ctr, unsigned& gen, int lane) {
    gen += 4u;
    asm volatile("s_waitcnt vmcnt(0) lgkmcnt(0)" ::: "memory");
    if (lane == 0) __hip_atomic_fetch_add((unsigned*)ctr, 1u, __ATOMIC_RELAXED, __HIP_MEMORY_SCOPE_WORKGROUP);
    while (true) {
        const unsigned v = __hip_atomic_load((unsigned*)ctr, __ATOMIC_RELAXED, __HIP_MEMORY_SCOPE_WORKGROUP);
        if ((int)(__builtin_amdgcn_readfirstlane(v) - gen) >= 0) break;
        __builtin_amdgcn_s_sleep(1);
    }
    asm volatile("s_waitcnt vmcnt(0) lgkmcnt(0)" ::: "memory");
}

__device__ __forceinline__ void scan_role(const Params& p, int chain, int half, LAS unsigned char* lds, LAS unsigned* ctr) {
    unsigned char* ws = p.ws;
    const int tid = fresh_tid(), lane = tid & 63, wid = tid >> 6;
    const int b = chain >> 3, h = chain & 7, tb = b * SEQ, cb = h * 64;
    const bf16_t* zs = (const bf16_t*)(ws + OFF_ZS); const bf16_t* kkb = (const bf16_t*)(ws + OFF_KK); const bf16_t* bbb = (const bf16_t*)(ws + OFF_BB);
    const float* dec = (const float*)(ws + OFF_DEC); bf16_t* yo = (bf16_t*)(ws + OFF_Y);
    const int stA = tid >> 3, colA = (tid & 7) * 8;
    const int stC0 = tid >> 4, colC = (tid & 15) * 4;
    const int stD = (tid & 127) >> 2, colD = (tid & 3) * 8;
    const bf16_t* srcR = zs + (size_t)(tb + stA) * 1792 + cb + colA;
    const bf16_t* srcK = srcR + 512;
    const bf16_t* srcKK = kkb + (size_t)(tb + stA) * 512 + cb + colA;
    const bf16_t* srcBB = bbb + (size_t)(tb + stA) * 512 + cb + colA;
    const float* srcW0 = dec + (size_t)(tb + stC0) * 512 + cb + colC;
    const float* srcW1 = srcW0 + (size_t)16 * 512;
    const bf16_t* srcV = zs + (size_t)(tb + stD) * 1792 + 1024 + cb + half * 32 + colD;
    const int ldR = stA * 256 + colA * 4, ldK = 16384 + ldR, ldKK = 24576 + ldR, ldBB = 32768 + ldR;
    const int ldW0 = 8192 + stC0 * 256 + colC * 4, ldW1 = ldW0 + 16 * 256;
    const int ldV = 40960 + stD * 128 + colD * 4;
    u32x4 rr, rk, rkk, rbb, rv = (u32x4){0u, 0u, 0u, 0u}; f32x4 rw0, rw1;
    auto gload = [&](int blk) {
        rr = *(const u32x4*)(srcR + (size_t)blk * 32 * 1792); rk = *(const u32x4*)(srcK + (size_t)blk * 32 * 1792);
        rkk = *(const u32x4*)(srcKK + (size_t)blk * 32 * 512); rbb = *(const u32x4*)(srcBB + (size_t)blk * 32 * 512);
        rw0 = *(const f32x4*)(srcW0 + (size_t)blk * 32 * 512); rw1 = *(const f32x4*)(srcW1 + (size_t)blk * 32 * 512);
        if (tid < 128) rv = *(const u32x4*)(srcV + (size_t)blk * 32 * 1792);
    };
    auto st8 = [&](LAS unsigned char* a, u32x4 x) {
        *(LAS f32x4*)a = (f32x4){bflo(x.x), bfhi(x.x), bflo(x.y), bfhi(x.y)};
        *(LAS f32x4*)(a + 16) = (f32x4){bflo(x.z), bfhi(x.z), bflo(x.w), bfhi(x.w)};
    };
    auto lstore = [&](int buf) {
        LAS unsigned char* base = lds + buf * SC_BUF;
        st8(base + ldR, rr); st8(base + ldK, rk); st8(base + ldKK, rkk); st8(base + ldBB, rbb);
        *(LAS f32x4*)(base + ldW0) = rw0; *(LAS f32x4*)(base + ldW1) = rw1;
        if (tid < 128) st8(base + ldV, rv);
    };
    const int rg = lane >> 4, kq = lane & 15, wv = __builtin_amdgcn_readfirstlane(wid), myrow = wv * 8 + rg * 2;
    f32x2_t Sa01 = {0.f, 0.f}, Sa23 = {0.f, 0.f}, Sb01 = {0.f, 0.f}, Sb23 = {0.f, 0.f};
    bf16_t* ycol = yo + (size_t)tb * 512 + cb + half * 32 + myrow;
    unsigned gen = 0u;
    gload(0); lstore(0);
    bar4(ctr, gen, lane);
    for (int blk = 0; blk < SEQ / 32; ++blk) {
        if (blk + 1 < SEQ / 32) gload(blk + 1);
        {
            LAS unsigned char* base = lds + (blk & 1) * SC_BUF;
            f32x4 nr4 = *(const LAS f32x4*)(base + kq * 16), nw4 = *(const LAS f32x4*)(base + 8192 + kq * 16), nk4 = *(const LAS f32x4*)(base + 16384 + kq * 16);
            f32x4 na4 = *(const LAS f32x4*)(base + 24576 + kq * 16), nb4 = *(const LAS f32x4*)(base + 32768 + kq * 16);
            f32x2_t nv2 = *(const LAS f32x2_t*)(base + 40960 + myrow * 4);
            for (int hq = 0; hq < 2; ++hq) {
            unsigned yacc = 0u;
#pragma unroll
            for (int j = 0; j < 16; ++j) {
                const f32x4 r4 = nr4, w4 = nw4, k4 = nk4, a4 = na4, b4 = nb4; const f32x2_t v2 = nv2;
                {
                    const int tn = (hq * 16 + j + 1) & 31;
                    nr4 = *(const LAS f32x4*)(base + tn * 256 + kq * 16); nw4 = *(const LAS f32x4*)(base + 8192 + tn * 256 + kq * 16); nk4 = *(const LAS f32x4*)(base + 16384 + tn * 256 + kq * 16);
                    na4 = *(const LAS f32x4*)(base + 24576 + tn * 256 + kq * 16); nb4 = *(const LAS f32x4*)(base + 32768 + tn * 256 + kq * 16);
                    nv2 = *(const LAS f32x2_t*)(base + 40960 + tn * 128 + myrow * 4);
                }
                __builtin_amdgcn_sched_barrier(0);
                const f32x2_t a01 = {a4[0], a4[1]}, a23 = {a4[2], a4[3]}, w01 = {w4[0], w4[1]}, w23 = {w4[2], w4[3]}, k01 = {k4[0], k4[1]}, k23 = {k4[2], k4[3]};
                const f32x2_t b01 = {b4[0], b4[1]}, b23 = {b4[2], b4[3]}, r01 = {r4[0], r4[1]}, r23 = {r4[2], r4[3]};
                f32x2_t ppa = Sa01 * a01; ppa = __builtin_elementwise_fma(Sa23, a23, ppa);
                f32x2_t ppb = Sb01 * a01; ppb = __builtin_elementwise_fma(Sb23, a23, ppb);
                const float pda = red16(ppa.x + ppa.y), pdb = red16(ppb.x + ppb.y);
                const f32x2_t npa = {-pda, -pda}, npb = {-pdb, -pdb}, va2 = {v2.x, v2.x}, vb2 = {v2.y, v2.y};
                Sa01 = __builtin_elementwise_fma(Sa01, w01, __builtin_elementwise_fma(npa, b01, va2 * k01));
                Sa23 = __builtin_elementwise_fma(Sa23, w23, __builtin_elementwise_fma(npa, b23, va2 * k23));
                Sb01 = __builtin_elementwise_fma(Sb01, w01, __builtin_elementwise_fma(npb, b01, vb2 * k01));
                Sb23 = __builtin_elementwise_fma(Sb23, w23, __builtin_elementwise_fma(npb, b23, vb2 * k23));
                f32x2_t yya = Sa01 * r01; yya = __builtin_elementwise_fma(Sa23, r23, yya);
                f32x2_t yyb = Sb01 * r01; yyb = __builtin_elementwise_fma(Sb23, r23, yyb);
                float ya0 = yya.x + yya.y, yb0 = yyb.x + yyb.y;
                asm volatile("" : "+v"(ya0)); asm volatile("" : "+v"(yb0));
                const float ya = red16(ya0), yb = red16(yb0);
                yacc = (kq == j) ? pk2(ya, yb) : yacc;
                __builtin_amdgcn_sched_barrier(0);
            }
            *(unsigned*)(ycol + (size_t)(blk * 32 + hq * 16 + kq) * 512) = yacc;
            }
        }
        if (blk + 1 < SEQ / 32) lstore((blk + 1) & 1);
        bar4(ctr, gen, lane);
    }
}

__device__ __forceinline__ void attn_role_unit(const Params& p, int b, int h, int qb, LAS unsigned char* lds, LAS unsigned* ctr, unsigned& gen) {
    const int tid = fresh_tid() - 256, lane = tid & 63, wid = tid >> 6, r = lane & 31, hh = lane >> 5;
    const bf16_t* q = (const bf16_t*)((const unsigned char*)p.out + DO_Q); const bf16_t* kn = (const bf16_t*)((const unsigned char*)p.out + DO_KN);
    const bf16_t* vT = (const bf16_t*)((const unsigned char*)p.out + DO_VT); const bf16_t* kpe = (const bf16_t*)((const unsigned char*)p.out + DO_KPE);
    bf16_t* ym = (bf16_t*)(p.ws + OFF_ZC);
    const int tb = b * SEQ, q0w = qb * 128 + wid * 32;
    bf16x8 Q[6];
    {
        const bf16_t* qrow = q + (size_t)(tb + q0w + r) * 768;
#pragma unroll
        for (int s = 0; s < 4; ++s) Q[s] = *(const bf16x8*)(qrow + h * 64 + s * 16 + hh * 8);
#pragma unroll
        for (int s = 4; s < 6; ++s) Q[s] = *(const bf16x8*)(qrow + 512 + h * 32 + (s - 4) * 16 + hh * 8);
    }
    f32x16 O[2];
#pragma unroll
    for (int i = 0; i < 16; ++i) { O[0][i] = 0.f; O[1][i] = 0.f; }
    float mrun = -INFINITY, lrun = 0.f;
    const int nt = 2 * (qb + 1);
    const bf16_t* ksrc[3]; int kstr[3], lk[3];
#pragma unroll
    for (int i = 0; i < 3; ++i) {
        const int id = tid + 256 * i, row = id / 12, c = id % 12;
        ksrc[i] = (c < 8) ? kn + (size_t)(tb + row) * 512 + h * 64 + c * 8 : kpe + (size_t)(tb + row) * 32 + (c - 8) * 8;
        kstr[i] = (c < 8) ? 512 * 64 : 32 * 64; lk[i] = row * 208 + c * 16;
    }
    const bf16_t* vsrc[2]; int lv[2];
#pragma unroll
    for (int i = 0; i < 2; ++i) { const int id = tid + 256 * i; vsrc[i] = vT + ((size_t)((b * 8 + h) * 64 + (id >> 3))) * 4096 + (id & 7) * 8; lv[i] = (id >> 3) * 136 + (id & 7) * 16; }
    u32x4 ak[3], av[2], bk[3], bv[2];
#define RV_GLOADK(G, kt) do { if ((kt) < nt) { _Pragma("unroll") for (int i_ = 0; i_ < 3; ++i_) G[i_] = *(const u32x4*)(ksrc[i_] + (size_t)(kt) * kstr[i_]); } } while (0)
#define RV_GLOADV(G, kt) do { if ((kt) < nt) { _Pragma("unroll") for (int i_ = 0; i_ < 2; ++i_) G[i_] = *(const u32x4*)(vsrc[i_] + (kt) * 64); } } while (0)
#define RV_LSTOREK(G, kt) do { if ((kt) < nt) { const int kb_ = ((kt) % 3) * AT_KB; _Pragma("unroll") for (int i_ = 0; i_ < 3; ++i_) *(LAS u32x4*)(lds + kb_ + lk[i_]) = G[i_]; } } while (0)
#define RV_LSTOREV(G, kt) do { if ((kt) < nt) { const int vb_ = AT_V0 + ((kt) & 1) * AT_VB; _Pragma("unroll") for (int i_ = 0; i_ < 2; ++i_) { \
        *(LAS u32x2*)(lds + vb_ + lv[i_]) = (u32x2){G[i_].x, G[i_].y}; *(LAS u32x2*)(lds + vb_ + lv[i_] + 8) = (u32x2){G[i_].z, G[i_].w}; } } } while (0)
    const int wq = __builtin_amdgcn_readfirstlane(q0w);
    f32x16 Sc[2], Sn[2];
    auto qk = [&](f32x16 (&S)[2], int kt) {
        const LAS unsigned char* Kb = lds + (kt % 3) * AT_KB;
#pragma unroll
        for (int i = 0; i < 16; ++i) { S[0][i] = 0.f; S[1][i] = 0.f; }
#pragma unroll
        for (int s = 0; s < 6; ++s) {
            const bf16x8 K0 = *(const LAS bf16x8*)(Kb + r * 208 + s * 32 + hh * 16);
            const bf16x8 K1 = *(const LAS bf16x8*)(Kb + (32 + r) * 208 + s * 32 + hh * 16);
            S[0] = __builtin_amdgcn_mfma_f32_32x32x16_bf16(K0, Q[s], S[0], 0, 0, 0);
            S[1] = __builtin_amdgcn_mfma_f32_32x32x16_bf16(K1, Q[s], S[1], 0, 0, 0);
        }
    };
    auto step = [&](int kt) {
        if (kt * 64 > wq + 31) return;
        if (kt * 64 + 63 > wq) {
            const int qi = q0w + r;
#pragma unroll
            for (int kb = 0; kb < 2; ++kb)
#pragma unroll
                for (int i = 0; i < 16; ++i) { const int key = kt * 64 + kb * 32 + (i >> 2) * 8 + hh * 4 + (i & 3); if (key > qi) Sc[kb][i] = -INFINITY; }
        }
        const LAS unsigned char* Vb = lds + AT_V0 + (kt & 1) * AT_VB;
        float mx = Sc[0][0];
#pragma unroll
        for (int i = 1; i < 16; ++i) mx = fmaxf(mx, Sc[0][i]);
#pragma unroll
        for (int i = 0; i < 16; ++i) mx = fmaxf(mx, Sc[1][i]);
        mx = fmaxf(mx, __shfl_xor(mx, 32));
        if (__builtin_amdgcn_ballot_w64(mx > mrun + 8.0f) != 0ull) {
            const float mnew = fmaxf(mrun, mx);
            const float alpha = __builtin_amdgcn_exp2f(mrun - mnew);
            lrun *= alpha;
#pragma unroll
            for (int i = 0; i < 16; ++i) { O[0][i] *= alpha; O[1][i] *= alpha; }
            mrun = mnew;
        }
        qk(Sn, kt + 1);
        f32x2_t ls2 = {0.f, 0.f}; const f32x2_t mn2 = {mrun, mrun};
#pragma unroll
        for (int kb = 0; kb < 2; ++kb)
#pragma unroll
            for (int i = 0; i < 16; i += 2) {
                f32x2_t t = (f32x2_t){Sc[kb][i], Sc[kb][i + 1]} - mn2;
                t.x = __builtin_amdgcn_exp2f(t.x); t.y = __builtin_amdgcn_exp2f(t.y);
                ls2 += t; Sc[kb][i] = t.x; Sc[kb][i + 1] = t.y;
            }
        lrun += ls2.x + ls2.y;
#pragma unroll
        for (int ks = 0; ks < 4; ++ks) {
            const int kb = ks >> 1, hf = ks & 1;
            u32x4 pw; pw.x = pk2(Sc[kb][hf * 8 + 0], Sc[kb][hf * 8 + 1]); pw.y = pk2(Sc[kb][hf * 8 + 2], Sc[kb][hf * 8 + 3]); pw.z = pk2(Sc[kb][hf * 8 + 4], Sc[kb][hf * 8 + 5]); pw.w = pk2(Sc[kb][hf * 8 + 6], Sc[kb][hf * 8 + 7]);
            const bf16x8 Pf = __builtin_bit_cast(bf16x8, pw);
#pragma unroll
            for (int db = 0; db < 2; ++db) {
                const LAS unsigned char* vp = Vb + (db * 32 + r) * 136 + (ks * 16 + hh * 4) * 2;
                const u32x2 va = *(const LAS u32x2*)vp, vb = *(const LAS u32x2*)(vp + 16);
                const bf16x8 Vf = __builtin_bit_cast(bf16x8, (u32x4){va.x, va.y, vb.x, vb.y});
                O[db] = __builtin_amdgcn_mfma_f32_32x32x16_bf16(Vf, Pf, O[db], 0, 0, 0);
            }
        }
        Sc[0] = Sn[0]; Sc[1] = Sn[1];
    };
    {
        u32x4 pk0[3];
        RV_GLOADK(pk0, 0);
        RV_GLOADK(ak, 1); RV_GLOADV(av, 0);
        bar4(ctr, gen, lane);
        RV_LSTOREK(pk0, 0);
        RV_LSTOREK(ak, 1); RV_LSTOREV(av, 0);
        RV_GLOADK(bk, 2); RV_GLOADV(bv, 1);
        bar4(ctr, gen, lane);
    }
    qk(Sc, 0);
    for (int kt = 0; kt < nt; kt += 2) {
        RV_GLOADK(ak, kt + 3); RV_GLOADV(av, kt + 2);
        step(kt);
        RV_LSTOREK(bk, kt + 2); RV_LSTOREV(bv, kt + 1);
        bar4(ctr, gen, lane);
        RV_GLOADK(bk, kt + 4); RV_GLOADV(bv, kt + 3);
        step(kt + 1);
        RV_LSTOREK(ak, kt + 3); RV_LSTOREV(av, kt + 2);
        bar4(ctr, gen, lane);
    }
    lrun += __shfl_xor(lrun, 32);
    const float inv = __builtin_amdgcn_rcpf(lrun);
    bf16_t* orow = ym + (size_t)(tb + q0w + r) * 512 + h * 64;
#pragma unroll
    for (int db = 0; db < 2; ++db)
#pragma unroll
        for (int g = 0; g < 4; ++g) {
            f32x4 v = (f32x4){O[db][g * 4 + 0], O[db][g * 4 + 1], O[db][g * 4 + 2], O[db][g * 4 + 3]} * inv;
            store4bf(orow + db * 32 + g * 8 + hh * 4, v);
        }
}

__device__ __forceinline__ void phase3_overlap(const Params& p, LAS unsigned char* lds) {
    const int wv = __builtin_amdgcn_readfirstlane((int)threadIdx.x >> 6);
    LAS unsigned* ctr = (LAS unsigned*)(lds + OV_CTR);
    for (int u = blockIdx.x; u < 256; u += gridDim.x) {
        __syncthreads();
        if (threadIdx.x < 2) ctr[threadIdx.x] = 0u;
        __syncthreads();
        const int chain = u >> 1, half = u & 1, b = chain >> 3, h = chain & 7;
        if (wv < 4) {
            scan_role(p, chain, half, lds, ctr);
        } else {
            unsigned gen = 0u;
            for (int i = 0; i < 8; ++i) {
                const int qa = half * 8 + i;
                attn_role_unit(p, b, h, 31 - qa, lds + OV_AT, ctr + 1, gen);
                attn_role_unit(p, b, h, qa, lds + OV_AT, ctr + 1, gen);
            }
        }
    }
    __syncthreads();
}

__device__ __forceinline__ void phase3(const Params& p, LAS unsigned char* lds) {
#ifndef NO_SCAN
    for (int u = blockIdx.x; u < 256; u += gridDim.x) scan_unit(p, u >> 1, u & 1, lds);
#ifdef REP_SCAN
    for (int u = blockIdx.x; u < 256; u += gridDim.x) scan_unit(p, u >> 1, u & 1, lds);
#endif
#endif
#ifndef NO_ATTN
    for (int u = blockIdx.x; u < 256; u += gridDim.x) {
        const int chain = u >> 1, half = u & 1, b = chain >> 3, h = chain & 7;
        for (int i = 0; i < 4; ++i) {
            const int qa = half * 4 + i;
            attn_unit(p, b, h, 15 - qa, lds);
            attn_unit(p, b, h, qa, lds);
        }
    }
#endif
}

__device__ __forceinline__ void phase4(const Params& p, LAS unsigned char* lds) {
    unsigned char* ws = p.ws;
    bf16_t* yb = (bf16_t*)(ws + OFF_Y); const bf16_t* ymb = (const bf16_t*)(ws + OFF_ZC); const bf16_t* zs = (const bf16_t*)(ws + OFF_ZS);
    const bf16_t* gb = (const bf16_t*)(ws + OFF_G); const float* bonus = (const float*)(ws + OFF_BONUS); const bf16_t* gates = (const bf16_t*)(ws + OFF_GATES);
    bf16_t* merged = (bf16_t*)(ws + OFF_KK);
    for (int pm = blockIdx.x; pm < NPAN; pm += gridDim.x) {
        const int R0 = pm * 256;
        __syncthreads();
        const int tid = fresh_tid();
        const int hd = (tid >> 4) & 7, l = tid & 15, c = hd * 64 + l * 4;
        const f32x4 lg = *(const f32x4*)(p.in[12] + c), lb = *(const f32x4*)(p.in[13] + c);
        for (int it0 = 0; it0 < 64; it0 += 4) {
            u32x2 y2[4], v2[4], g2[4]; float bsv[4];
#pragma unroll
            for (int j = 0; j < 4; ++j) {
                const int row = R0 + (((it0 + j) * 32 + (tid >> 4)) >> 3);
                y2[j] = *(const u32x2*)(yb + (size_t)row * 512 + c); v2[j] = *(const u32x2*)(zs + (size_t)row * 1792 + 1024 + c); g2[j] = *(const u32x2*)(gb + (size_t)row * 512 + c);
                bsv[j] = bonus[(size_t)row * 8 + hd];
            }
#pragma unroll
            for (int j = 0; j < 4; ++j) {
                const int row = R0 + (((it0 + j) * 32 + (tid >> 4)) >> 3);
                float y[4] = {bflo(y2[j].x), bfhi(y2[j].x), bflo(y2[j].y), bfhi(y2[j].y)};
                const float vv[4] = {bflo(v2[j].x), bfhi(v2[j].x), bflo(v2[j].y), bfhi(v2[j].y)};
                const float gg[4] = {bflo(g2[j].x), bfhi(g2[j].x), bflo(g2[j].y), bfhi(g2[j].y)};
                float s = (y[0] + y[1]) + (y[2] + y[3]);
                s = red16(s);
                const float mean = s * (1.0f / 64.0f);
                float qv = 0.f;
#pragma unroll
                for (int q = 0; q < 4; ++q) { y[q] -= mean; qv += y[q] * y[q]; }
                qv = red16(qv);
                const float rstd = rsqrtf(qv * (1.0f / 64.0f) + 64e-5f);
                f32x4 o;
#pragma unroll
                for (int q = 0; q < 4; ++q) o[q] = (y[q] * rstd * lg[q] + lb[q] + bsv[j] * vv[q]) * gg[q];
                store4bf(yb + (size_t)row * 512 + c, o);
            }
        }
        __syncthreads();
        for (int pn = 0; pn < 4; ++pn) {
            gemm_unit<true>(yb, 512, (const bf16_t*)(ws + OFF_WPR), 512, 512, R0, pn * 256, lds, [&](f32x4 (&acc)[2][2][4][2], int wr, int wc, int fr, int fq) {
#pragma unroll
                for (int ai = 0; ai < 2; ++ai)
#pragma unroll
                    for (int m = 0; m < 4; ++m) {
                        const int row = R0 + ai * 128 + wr * 64 + m * 16 + fr;
#pragma unroll
                        for (int bj = 0; bj < 2; ++bj) {
                                const int c = pn * 256 + bj * 128 + wc * 32 + fq * 8;
                                const u32x4 g4 = *(const u32x4*)(gates + (size_t)row * 2048 + c);
                                const f32x4 gt0 = (f32x4){bflo(g4.x), bfhi(g4.x), bflo(g4.y), bfhi(g4.y)}, gt1 = (f32x4){bflo(g4.z), bfhi(g4.z), bflo(g4.w), bfhi(g4.w)};
                                store8bf(merged + (size_t)row * 1024 + c, acc[ai][bj][m][0] * gt0, acc[ai][bj][m][1] * gt1);
                            }
                    }
            }, pn > 0, pn + 1 < 4, R0, (pn + 1) * 256);
        }
        for (int pn = 0; pn < 4; ++pn) {
            gemm_unit<true>(ymb, 512, (const bf16_t*)(ws + OFF_WPM), 512, 512, R0, pn * 256, lds, [&](f32x4 (&acc)[2][2][4][2], int wr, int wc, int fr, int fq) {
#pragma unroll
                for (int ai = 0; ai < 2; ++ai)
#pragma unroll
                    for (int m = 0; m < 4; ++m) {
                        const int row = R0 + ai * 128 + wr * 64 + m * 16 + fr;
#pragma unroll
                        for (int bj = 0; bj < 2; ++bj) {
                                const int c = pn * 256 + bj * 128 + wc * 32 + fq * 8;
                                const u32x4 g4 = *(const u32x4*)(gates + (size_t)row * 2048 + 1024 + c);
                                const f32x4 gt0 = (f32x4){bflo(g4.x), bfhi(g4.x), bflo(g4.y), bfhi(g4.y)}, gt1 = (f32x4){bflo(g4.z), bfhi(g4.z), bflo(g4.w), bfhi(g4.w)};
                                const u32x4 p4 = *(const u32x4*)(merged + (size_t)row * 1024 + c);
                                const f32x4 pt0 = (f32x4){bflo(p4.x), bfhi(p4.x), bflo(p4.y), bfhi(p4.y)}, pt1 = (f32x4){bflo(p4.z), bfhi(p4.z), bflo(p4.w), bfhi(p4.w)};
                                store8bf(merged + (size_t)row * 1024 + c, pt0 + acc[ai][bj][m][0] * gt0, pt1 + acc[ai][bj][m][1] * gt1);
                            }
                    }
            }, pn > 0, pn + 1 < 4, R0, (pn + 1) * 256);
        }
    }
}

__device__ __forceinline__ void row_stats_acc(const f32x4 (&v)[2][2], LAS float* stat, int rloc, int fq) {
    float s = 0.f, q = 0.f;
#pragma unroll
    for (int bj = 0; bj < 2; ++bj)
#pragma unroll
        for (int n = 0; n < 2; ++n)
#pragma unroll
            for (int j = 0; j < 4; ++j) { s += v[bj][n][j]; q += v[bj][n][j] * v[bj][n][j]; }
    s += __shfl_xor(s, 16); s += __shfl_xor(s, 32); q += __shfl_xor(q, 16); q += __shfl_xor(q, 32);
    if (fq == 0) { atomicAdd((float*)(stat + rloc * 2), s); atomicAdd((float*)(stat + rloc * 2 + 1), q); }
}

template <int PART> __device__ __forceinline__ void phase5(const Params& p, LAS unsigned char* lds) {
    unsigned char* ws = p.ws;
    const bf16_t* merged = (const bf16_t*)(ws + OFF_KK); bf16_t* hbf = (bf16_t*)(ws + OFF_DEC); bf16_t* act = (bf16_t*)(ws + OFF_ACT);
    LAS float* stat = (LAS float*)(lds + 131072);
    const float* x = p.in[0];
    if (PART == 1) {
        const bool blocked = gridDim.x == 256;
        const int nunits = blocked ? 22 : ((NPAN - (int)blockIdx.x + (int)gridDim.x - 1) / (int)gridDim.x) * 22;
        for (int ui = 0; ui < nunits; ++ui) {
            int pm, pn;
            int npm, npn;
            if (blocked) { const int x = blockIdx.x & 7, li = blockIdx.x >> 3, u = 32 * ui + li, pg = u / (22 * PGRP), s = u % (22 * PGRP); pn = s / PGRP; pm = 32 * x + PGRP * pg + (s % PGRP);
                           const int u2 = u + 32, pg2 = u2 / (22 * PGRP), s2 = u2 % (22 * PGRP); npn = s2 / PGRP; npm = 32 * x + PGRP * pg2 + (s2 % PGRP); }
            else { pm = blockIdx.x + (ui / 22) * gridDim.x; pn = ui % 22; npm = blockIdx.x + ((ui + 1) / 22) * gridDim.x; npn = (ui + 1) % 22; }
            const int R0 = pm * 256;
            {
                {
                    gemm_unit<true>(hbf, 1024, (const bf16_t*)(ws + OFF_WGU), 1024, 1024, R0, pn * 256, lds, [&](f32x4 (&acc)[2][2][4][2], int wr, int wc, int fr, int fq) {
#pragma unroll
                        for (int ai = 0; ai < 2; ++ai)
#pragma unroll
                            for (int m = 0; m < 4; ++m) {
                                const int row = R0 + ai * 128 + wr * 64 + m * 16 + fr;
                                f32x4 o[2];
#pragma unroll
                                for (int n = 0; n < 2; ++n) {
                                    const f32x4 g = acc[ai][0][m][n], u = acc[ai][1][m][n];
#pragma unroll
                                    for (int j = 0; j < 4; ++j) o[n][j] = g[j] * sigmoidf_(g[j]) * u[j];
                                }
                                store8bf(act + (size_t)row * 2816 + pn * 128 + wc * 32 + fq * 8, o[0], o[1]);
                            }
                    }, ui > 0, ui + 1 < nunits, npm * 256, npn * 256);
                }
            }
        }
        return;
    }
    for (int pm = blockIdx.x; pm < NPAN; pm += gridDim.x) {
        const int R0 = pm * 256;
        {
            constexpr int stage = PART == 0 ? 0 : 1;
            __syncthreads();
            stat[fresh_tid()] = 0.f;
            __syncthreads();
            for (int pn = 0; pn < 4; ++pn) {
                const bf16_t* A = stage == 0 ? merged : act; const int lda = stage == 0 ? 1024 : 2816; const int K = lda;
                const bf16_t* Bt = (const bf16_t*)(ws + (stage == 0 ? OFF_WOUT : OFF_WD));
                const float* res = stage == 0 ? x : p.out;
                const float* mrs = (const float*)(ws + OFF_RSTDQ);
                gemm_unit<true>(A, lda, Bt, K, K, R0, pn * 256, lds, [&](f32x4 (&acc)[2][2][4][2], int wr, int wc, int fr, int fq) {
#pragma unroll
                    for (int ai = 0; ai < 2; ++ai)
#pragma unroll
                        for (int m = 0; m < 4; ++m) {
                            const int rloc = ai * 128 + wr * 64 + m * 16 + fr, row = R0 + rloc;
                            f32x4 v[2][2];
                            f32x2_t mr = {0.f, 1.f};
                            if (stage == 1) mr = *(const f32x2_t*)(mrs + (size_t)row * 2);
#pragma unroll
                            for (int bj = 0; bj < 2; ++bj)
#pragma unroll
                                for (int n = 0; n < 2; ++n) {
                                    const int col = pn * 256 + bj * 128 + wc * 32 + n * 16 + fq * 4;
                                    const size_t off = (size_t)row * 1024 + col;
                                    f32x4 rv = *(const f32x4*)(res + off);
                                    if (stage == 1) rv = (rv - mr.x) * mr.y * *(const f32x4*)(p.in[21] + col) + *(const f32x4*)(p.in[22] + col);
                                    v[bj][n] = rv * ALPHA_F + acc[ai][bj][m][n];
                                    *(f32x4*)(p.out + off) = v[bj][n];
                                }
                            row_stats_acc(v, stat, rloc, fq);
                        }
                }, pn > 0, pn + 1 < 4, R0, (pn + 1) * 256);
            }
            __syncthreads();
            const float* lg = p.in[stage == 0 ? 21 : 26]; const float* lb = p.in[stage == 0 ? 22 : 27];
            const int tid = fresh_tid(), lane = tid & 63, wid = tid >> 6;
            f32x4 gpar[4], bpar[4];
#pragma unroll
            for (int j = 0; j < 4; ++j) { gpar[j] = *(const f32x4*)(lg + j * 256 + lane * 4); bpar[j] = *(const f32x4*)(lb + j * 256 + lane * 4); }
            for (int rr = 0; rr < 32; rr += 2) {
                f32x4 v[2][4];
#pragma unroll
                for (int q = 0; q < 2; ++q)
#pragma unroll
                    for (int j = 0; j < 4; ++j) v[q][j] = *(const f32x4*)(p.out + (size_t)(R0 + wid * 32 + rr + q) * 1024 + j * 256 + lane * 4);
#pragma unroll
                for (int q = 0; q < 2; ++q) {
                    const int rloc = wid * 32 + rr + q, row = R0 + rloc;
                    const float mean = stat[rloc * 2] * (1.0f / 1024.0f);
                    const float var = fmaxf(stat[rloc * 2 + 1] * (1.0f / 1024.0f) - mean * mean, 0.f);
                    const float rstd = rsqrtf(var + 1e-5f);
                    float* orow = p.out + (size_t)row * 1024;
                    if (stage == 0 && lane == 0) *(f32x2_t*)((float*)(ws + OFF_RSTDQ) + (size_t)row * 2) = (f32x2_t){mean, rstd};
#pragma unroll
                    for (int j = 0; j < 4; ++j) {
                        const int c = j * 256 + lane * 4;
                        const f32x4 o = (v[q][j] - mean) * rstd * gpar[j] + bpar[j];
                        if (stage == 0) store4bf(hbf + (size_t)row * 1024 + c, o);
                        else *(f32x4*)(orow + c) = o;
                    }
                }
            }
        }
    }
}

#ifdef DBG
__device__ __forceinline__ void phase_dbg(const Params& p) {
    const size_t gt = (size_t)blockIdx.x * 512 + threadIdx.x, NT = (size_t)gridDim.x * 512;
    for (size_t i = gt; i < (size_t)T_TOK * 1024; i += NT) {
        const size_t t = i >> 10; const int c = (int)(i & 1023);
        float v;
#if DBG == 1
        v = bf1(((const bf16_t*)(p.ws + OFF_ZS))[t * 1792 + c]);
#elif DBG == 2
        v = c < 512 ? bf1(((const bf16_t*)(p.ws + OFF_KK))[t * 512 + c]) : bf1(((const bf16_t*)(p.ws + OFF_ZS))[t * 1792 + c]);
#elif DBG == 3
#if defined(NO_ATTN)
        v = bf1(((const bf16_t*)(p.ws + OFF_Y))[t * 512 + (c & 511)]);
#elif defined(NO_SCAN)
        v = bf1(((const bf16_t*)(p.ws + OFF_ZC))[t * 512 + (c & 511)]);
#else
        v = c < 512 ? bf1(((const bf16_t*)(p.ws + OFF_Y))[t * 512 + c]) : bf1(((const bf16_t*)(p.ws + OFF_ZC))[t * 512 + c - 512]);
#endif
#else
        v = bf1(((const bf16_t*)(p.ws + OFF_KK))[t * 1024 + c]);
#endif
        p.out[i] = v;
    }
}
#endif
__global__ void __launch_bounds__(512) mega_fwd(Params p) {
    extern __shared__ __attribute__((aligned(16))) unsigned char dyn_lds[];
    LAS unsigned char* lds = (LAS unsigned char*)dyn_lds;
    cg::grid_group grid = cg::this_grid();
    const int lo = p.ph_lo, hi = p.ph_hi;
    if (lo <= 0 && 0 < hi) phase0(p, lds);
    if (lo < 1 && 1 < hi) grid.sync();
    if (lo <= 1 && 1 < hi) phase1(p, lds);
#ifdef REP_P1
    grid.sync(); phase1(p, lds);
#endif
    if (lo < 2 && 2 < hi) grid.sync();
    if (lo <= 2 && 2 < hi) phase2(p, lds);
    if (lo < 3 && 3 < hi) grid.sync();
#if P3_OVERLAP
    if (lo <= 3 && 3 < hi) phase3_overlap(p, lds);
#else
    if (lo <= 3 && 3 < hi) phase3(p, lds);
#endif
#ifdef REP_P3
    grid.sync(); phase3(p, lds);
#endif
    if (lo < 4 && 4 < hi) grid.sync();
    if (lo <= 4 && 4 < hi) phase4(p, lds);
    if (lo < 5 && 5 < hi) __syncthreads();
    if (lo <= 5 && 5 < hi) phase5<0>(p, lds);
    if (lo < 6 && 6 < hi) grid.sync();
    if (lo <= 6 && 6 < hi) phase5<1>(p, lds);
    if (lo < 7 && 7 < hi) grid.sync();
    if (lo <= 7 && 7 < hi) phase5<2>(p, lds);
#ifdef DBG
    if (lo == 9) phase_dbg(p);
#endif
}


#ifndef N_LAUNCHES
#define N_LAUNCHES 1
#endif
extern "C" void kernel_launch(void* const* d_in, const int* in_sizes, int n_in, void* d_out, int out_size, void* d_ws, size_t ws_size, hipStream_t stream) {
    static int grid = 0;
    if (grid == 0) {
        int dev = 0, cus = 0, per_cu = 0;
        hipGetDevice(&dev);
        hipDeviceGetAttribute(&cus, hipDeviceAttributeMultiprocessorCount, dev);
        hipFuncSetAttribute((const void*)mega_fwd, hipFuncAttributeMaxDynamicSharedMemorySize, LDS_BYTES);
        hipOccupancyMaxActiveBlocksPerMultiprocessor(&per_cu, (const void*)mega_fwd, 512, LDS_BYTES);
        if (per_cu < 1) { fprintf(stderr, "kernel_launch: occupancy query says %d blocks/CU\n", per_cu); per_cu = 1; }
        grid = cus * 1;
        if (grid > 256) grid = 256;
        (void)hipGetLastError();
    }
    Params p{};
    for (int i = 0; i < 28; ++i) p.in[i] = (const float*)d_in[i];
    p.out = (float*)d_out; p.ws = (unsigned char*)d_ws;
#if N_LAUNCHES == 1
    p.ph_lo = 0; p.ph_hi = 8;
    void* args[] = {&p};
    hipError_t e = hipLaunchCooperativeKernel((const void*)mega_fwd, dim3(grid), dim3(512), args, LDS_BYTES, stream);
    if (e != hipSuccess) fprintf(stderr, "cooperative launch failed: %s (grid %d)\n", hipGetErrorString(e), grid);
#else
#ifdef DBG
    for (int ph = 0; ph <= DBG; ++ph) {
        p.ph_lo = ph; p.ph_hi = ph + 1;
        hipLaunchKernelGGL(mega_fwd, dim3(grid), dim3(512), LDS_BYTES, stream, p);
    }
    p.ph_lo = 9; p.ph_hi = 10;
    hipLaunchKernelGGL(mega_fwd, dim3(grid), dim3(512), LDS_BYTES, stream, p);
#else
    for (int ph = 0; ph < 8; ++ph) {
        p.ph_lo = ph; p.ph_hi = ph + 1;
        hipLaunchKernelGGL(mega_fwd, dim3(grid), dim3(512), LDS_BYTES, stream, p);
    }
#endif
#endif
}
```
